# Optimizing an MI355X kernel written in HIP

```python
import math
import jax, jax.numpy as jnp
from jax import lax
import numpy as np

D_MODEL = 1024
BATCH = 4
SEQ = 8192
DEPTH = 1

DA_HEADS = 8
DA_HEAD_DIM = 64
DA_V_DIM = 2 * DA_HEAD_DIM
DA_QK_W = DA_HEADS * 2 * DA_HEAD_DIM
DA_V_W = DA_HEADS * DA_V_DIM
Q_BLOCK = 128
DIL_PAIRS = ((128, 1), (512, 4), (2048, 16))
DIL_HEADS_PER_GROUP = 4
DIL_HEADS = DIL_HEADS_PER_GROUP * len(DIL_PAIRS)
DIL_HEAD_DIM = 64
DIL_W = DIL_HEADS * DIL_HEAD_DIM
DIL_OUT_W = DIL_HEADS_PER_GROUP * DIL_HEAD_DIM
N_BRANCH = 2
IN_COLS = 2 * DA_QK_W + DA_V_W + 3 * DIL_W + N_BRANCH * D_MODEL
ROPE_THETA = 500000.0
ROT_DIM = 16
D_FF = 2816
EPS = 1e-6
NEG = -1e30

kernel_name = "hybrid_diffattn_dilated_macaron_block"


def rmsnorm(x, g):
    xf = x.astype(jnp.float32)
    y = xf * lax.rsqrt(jnp.mean(xf * xf, axis=-1, keepdims=True) + EPS)
    return (y * g.astype(jnp.float32)).astype(x.dtype)


def rope_tables(positions, dtype):
    inv = ROPE_THETA ** (-(jnp.arange(0, ROT_DIM, 2, dtype=jnp.float32) / ROT_DIM))
    ang = positions.astype(jnp.float32)[..., None] * inv
    return jnp.cos(ang)[:, :, None, :].astype(dtype), jnp.sin(ang)[:, :, None, :].astype(dtype)


def partial_rope(t, cos, sin):
    half = ROT_DIM // 2
    t1, t2, tp = t[..., :half], t[..., half:ROT_DIM], t[..., ROT_DIM:]
    return jnp.concatenate([t1 * cos - t2 * sin, t2 * cos + t1 * sin, tp], axis=-1)


def swiglu(h, w_gu, w_down):
    g, u = jnp.split(h @ w_gu, 2, axis=-1)
    return (jax.nn.silu(g) * u) @ w_down


def diff_attention(q, k, v, lam):
    B, S, H, _, dh = q.shape
    nblk = S // Q_BLOCK
    scale = 1.0 / math.sqrt(dh)
    qb = q.reshape(B, nblk, Q_BLOCK, H, 2, dh).transpose(1, 0, 2, 3, 4, 5)

    def block(qblk):
        s = jnp.einsum('bqhcd,bkhcd->bhcqk', qblk, k, preferred_element_type=jnp.float32) * scale
        p = jax.nn.softmax(s, axis=-1)
        a = p[:, :, 0] - lam * p[:, :, 1]
        return jnp.einsum('bhqk,bkhe->bqhe', a.astype(v.dtype), v,
                          preferred_element_type=jnp.float32).astype(v.dtype)

    o = lax.map(block, qb)
    return o.transpose(1, 0, 2, 3, 4).reshape(B, S, H, 2 * dh)


def dilated_window_attention(q, k, v, dil, half):
    B, S, Hg, dh = q.shape
    L = S // dil
    N = B * dil
    blk = half
    nb = -(-L // blk)
    Lp = nb * blk
    scale = 1.0 / math.sqrt(dh)

    def fold(t):
        return t.reshape(B, L, dil, Hg, dh).transpose(0, 2, 1, 3, 4).reshape(N, L, Hg, dh)

    qf, kf, vf = fold(q), fold(k), fold(v)
    qb = jnp.pad(qf, ((0, 0), (0, Lp - L), (0, 0), (0, 0))).reshape(N, nb, blk, Hg, dh)

    def ctx(t):
        tp = jnp.pad(t, ((0, 0), (blk, Lp - L + blk), (0, 0), (0, 0))).reshape(N, nb + 2, blk, Hg, dh)
        return jnp.concatenate([tp[:, :-2], tp[:, 1:-1], tp[:, 2:]], axis=2)

    kc, vc = ctx(kf), ctx(vf)
    s = jnp.einsum('nbqhd,nbkhd->nbhqk', qb, kc, preferred_element_type=jnp.float32) * scale
    qpos = jnp.arange(nb)[:, None] * blk + jnp.arange(blk)[None, :]
    kpos = (jnp.arange(nb)[:, None] - 1) * blk + jnp.arange(3 * blk)[None, :]
    valid = ((jnp.abs(kpos[:, None, :] - qpos[:, :, None]) <= half)
             & (kpos >= 0)[:, None, :] & (kpos < L)[:, None, :])
    s = jnp.where(valid[None, :, None], s, NEG)
    m = jnp.max(s, axis=-1, keepdims=True)
    e = jnp.exp(s - m)
    l = jnp.sum(e, axis=-1)
    o = jnp.einsum('nbhqk,nbkhd->nbqhd', e.astype(v.dtype), vc, preferred_element_type=jnp.float32)
    o = o / l.transpose(0, 1, 3, 2)[..., None]
    lse = (m[..., 0] + jnp.log(l)).transpose(0, 1, 3, 2)

    def unfold(t):
        t = t.reshape((N, Lp) + t.shape[3:])[:, :L]
        t = t.reshape((B, dil, L) + t.shape[2:])
        return jnp.swapaxes(t, 1, 2).reshape((B, S) + t.shape[3:])

    return unfold(o).astype(q.dtype), unfold(lse)


def setup_inputs(seed: int = 0) -> dict:
    key = jax.random.key(seed)
    ks = jax.random.split(key, 24)
    f32 = jnp.float32

    def w(k, shape, fan_in):
        return jax.random.normal(k, shape, f32) * fan_in ** -0.5

    def gain(k, shape):
        return 1.0 + 0.05 * jax.random.normal(k, shape, f32)

    return {
        "x": jax.random.normal(ks[0], (BATCH, SEQ, D_MODEL), f32),
        "positions": jnp.broadcast_to(jnp.arange(SEQ, dtype=jnp.int32), (BATCH, SEQ)),
        "w_in": w(ks[1], (DEPTH, D_MODEL, IN_COLS), D_MODEL),
        "lambda_q1": 0.1 * jax.random.normal(ks[2], (DEPTH, DA_HEAD_DIM), f32),
        "lambda_k1": 0.1 * jax.random.normal(ks[3], (DEPTH, DA_HEAD_DIM), f32),
        "lambda_q2": 0.1 * jax.random.normal(ks[4], (DEPTH, DA_HEAD_DIM), f32),
        "lambda_k2": 0.1 * jax.random.normal(ks[5], (DEPTH, DA_HEAD_DIM), f32),
        "g_subln": gain(ks[6], (DEPTH, DA_V_DIM)),
        "w_proj_a": w(ks[7], (DEPTH, DA_V_W, D_MODEL), DA_V_W),
        "w_proj_b": w(ks[8], (DEPTH, DIL_OUT_W, D_MODEL), DIL_OUT_W),
        "w_out": w(ks[9], (DEPTH, D_MODEL, D_MODEL), D_MODEL),
        "w_gu1": w(ks[10], (DEPTH, D_MODEL, 2 * D_FF), D_MODEL),
        "w_down1": w(ks[11], (DEPTH, D_FF, D_MODEL), D_FF),
        "w_gu2": w(ks[12], (DEPTH, D_MODEL, 2 * D_FF), D_MODEL),
        "w_down2": w(ks[13], (DEPTH, D_FF, D_MODEL), D_FF),
        "g_pre_ffn1": gain(ks[14], (DEPTH, D_MODEL)),
        "g_post_ffn1": gain(ks[15], (DEPTH, D_MODEL)),
        "g_pre_mix": gain(ks[16], (DEPTH, D_MODEL)),
        "g_post_mix": gain(ks[17], (DEPTH, D_MODEL)),
        "g_pre_ffn2": gain(ks[18], (DEPTH, D_MODEL)),
        "g_post_ffn2": gain(ks[19], (DEPTH, D_MODEL)),
    }


def reference(x, positions, w_in, lambda_q1, lambda_k1, lambda_q2, lambda_k2, g_subln,
              w_proj_a, w_proj_b, w_out, w_gu1, w_down1, w_gu2, w_down2,
              g_pre_ffn1, g_post_ffn1, g_pre_mix, g_post_mix, g_pre_ffn2, g_post_ffn2):
    B, S, D = x.shape
    cos, sin = rope_tables(positions, x.dtype)
    cuts = [int(c) for c in np.cumsum([DA_QK_W, DA_QK_W, DA_V_W, DIL_W, DIL_W, DIL_W, D_MODEL])]

    for l in range(DEPTH):
        lambda_init = 0.8 - 0.6 * math.exp(-0.3 * l)

        h = rmsnorm(x, g_pre_ffn1[l])
        x = x + 0.5 * rmsnorm(swiglu(h, w_gu1[l], w_down1[l]), g_post_ffn1[l])

        h = rmsnorm(x, g_pre_mix[l])
        z = h @ w_in[l]
        qa, ka, va, qd, kd, vd, ga, gb = jnp.split(z, cuts, axis=-1)

        qa = partial_rope(qa.reshape(B, S, 2 * DA_HEADS, DA_HEAD_DIM), cos, sin)
        ka = partial_rope(ka.reshape(B, S, 2 * DA_HEADS, DA_HEAD_DIM), cos, sin)
        qa = qa.reshape(B, S, DA_HEADS, 2, DA_HEAD_DIM)
        ka = ka.reshape(B, S, DA_HEADS, 2, DA_HEAD_DIM)
        va = va.reshape(B, S, DA_HEADS, DA_V_DIM)
        lam = (jnp.exp(jnp.dot(lambda_q1[l], lambda_k1[l]).astype(jnp.float32))
               - jnp.exp(jnp.dot(lambda_q2[l], lambda_k2[l]).astype(jnp.float32)) + lambda_init)
        oa = diff_attention(qa, ka, va, lam)
        oa = (rmsnorm(oa, g_subln[l]) * (1.0 - lambda_init)).reshape(B, S, DA_V_W)

        qd = partial_rope(qd.reshape(B, S, DIL_HEADS, DIL_HEAD_DIM), cos, sin)
        kd = partial_rope(kd.reshape(B, S, DIL_HEADS, DIL_HEAD_DIM), cos, sin)
        vd = vd.reshape(B, S, DIL_HEADS, DIL_HEAD_DIM)
        outs, lses = [], []
        for gi, (win, dil) in enumerate(DIL_PAIRS):
            hs = slice(gi * DIL_HEADS_PER_GROUP, (gi + 1) * DIL_HEADS_PER_GROUP)
            o_g, lse_g = dilated_window_attention(qd[:, :, hs], kd[:, :, hs], vd[:, :, hs],
                                                  dil, win // (2 * dil))
            outs.append(o_g)
            lses.append(lse_g)
        wts = jax.nn.softmax(jnp.stack(lses, axis=0), axis=0)
        od = jnp.sum(wts[..., None].astype(x.dtype) * jnp.stack(outs, axis=0), axis=0)
        od = od.reshape(B, S, DIL_OUT_W)

        merged = jax.nn.sigmoid(ga) * (oa @ w_proj_a[l]) + jax.nn.sigmoid(gb) * (od @ w_proj_b[l])
        x = x + rmsnorm(merged @ w_out[l], g_post_mix[l])

        h = rmsnorm(x, g_pre_ffn2[l])
        x = x + 0.5 * rmsnorm(swiglu(h, w_gu2[l], w_down2[l]), g_post_ffn2[l])

    return x
```

```cpp
#include <hip/hip_runtime.h>
#include <hip/hip_cooperative_groups.h>
#include <cstdio>
#include <cstdint>
namespace cg = cooperative_groups;

#ifndef MK_N_LAUNCHES
#define MK_N_LAUNCHES 1
#endif

#define LAS __attribute__((address_space(3)))
typedef unsigned short bf16_t;
typedef short bf16x8 __attribute__((ext_vector_type(8)));
typedef short s16x4 __attribute__((ext_vector_type(4)));
typedef float f32x4 __attribute__((ext_vector_type(4)));
typedef float f32x16 __attribute__((ext_vector_type(16)));
typedef unsigned u32x4 __attribute__((ext_vector_type(4)));
typedef unsigned u32x2 __attribute__((ext_vector_type(2)));
typedef float f32x2_t __attribute__((ext_vector_type(2)));
typedef __bf16 bf16x2_t __attribute__((ext_vector_type(2)));

constexpr int BATCH = 4, SEQ = 8192, DM = 1024, MROWS = BATCH * SEQ, DFF = 2816, NGU = 2 * DFF, NIN = 7424;
constexpr int ZP = 5376;
constexpr int GP = 2048;
constexpr int ZC_KA = 1024, ZC_VA = 2048, ZC_QD = 3072, ZC_KD = 3840, ZC_VD = 4608;
constexpr float EPS = 1e-6f;
constexpr float LOG2E = 1.4426950408889634f;
constexpr float C2 = 0.125f * LOG2E;
constexpr float LAMBDA_INIT = 0.2f;

constexpr size_t MiB = 1u << 20;
constexpr size_t WS_ROPE = 1 * MiB;
constexpr size_t WS_WIN = 4 * MiB;
constexpr size_t WS_WPA = 19 * MiB;
constexpr size_t WS_WPB = 21 * MiB;
constexpr size_t WS_WOUT = 22 * MiB;
constexpr size_t WS_WGU2 = 24 * MiB;
constexpr size_t WS_WD2 = 35 * MiB;
constexpr size_t WS_XN = 41 * MiB;
constexpr size_t WS_Y1 = 105 * MiB;
constexpr size_t WS_Z = 169 * MiB;
constexpr size_t WS_END = 505 * MiB;
constexpr size_t OUT_WGU1 = 0, OUT_WD1 = 11 * MiB;

constexpr int LDS_BYTES = 139264;
constexpr int NTHREADS = 512;

__device__ __forceinline__ unsigned cvtpk(float lo, float hi) { f32x2_t v = {lo, hi}; bf16x2_t b = __builtin_convertvector(v, bf16x2_t); return __builtin_bit_cast(unsigned, b); }
__device__ __forceinline__ float bflo(unsigned w) { return __uint_as_float(w << 16); }
__device__ __forceinline__ float bfhi(unsigned w) { return __uint_as_float(w & 0xffff0000u); }
__device__ __forceinline__ float fast_rcp(float x) { return __builtin_amdgcn_rcpf(x); }
__device__ __forceinline__ float fast_exp2(float x) { return __builtin_amdgcn_exp2f(x); }
__device__ __forceinline__ float sigmoidf_(float x) { return fast_rcp(1.f + fast_exp2(-x * LOG2E)); }
__device__ __forceinline__ float wave_sum(float v) {
#pragma unroll
    for (int o = 1; o < 64; o <<= 1) v += __shfl_xor(v, o);
    return v;
}

namespace pg8 {
constexpr int BM = 256, BK = 64, HALF = 128, HTB = HALF * BK * 2, STAGE_BYTES = 8 * HTB, NXCD = 8, WGM = 4;
__host__ __device__ __forceinline__ int lds_byte(int r, int c) { const int st = (r >> 4) * 2 + (c >> 5), rr = r & 15, cc = c & 31, ob = rr * 64 + cc * 2; return st * 1024 + (ob ^ (((ob >> 9) & 1) << 5)); }
__host__ __device__ __forceinline__ void stage_rc(int b, int& R, int& C) { const int st = b / 1024, sb = b % 1024, swz = sb ^ (((sb >> 9) & 1) << 5); R = (st >> 1) * 16 + swz / 64; C = (st & 1) * 32 + (swz % 64) / 2; }
__host__ __device__ __forceinline__ int perm32(int rho) { const int n = rho >> 4, i = rho & 15; return 8 * (i >> 2) + 4 * n + (i & 3); }

struct Unit { int pm, pn; };
struct Gemm { const bf16_t* A; const bf16_t* Bt; int M, N, K, lda; };

struct StaticOrder {
    int nM, nN, nwg, G, c;
    __device__ void init(int M, int N, int G_, int c_) { nM = M / BM; nN = N / BM; nwg = nM * nN; G = G_; c = c_; }
    __device__ bool next(int i, Unit& u) const {
        const long L = (long)i * G + c; if (L >= nwg) return false;
        int wgid = (int)L; { const int q = nwg / NXCD, r = nwg % NXCD, xcd = wgid % NXCD, off = wgid / NXCD; wgid = (xcd < r ? xcd * (q + 1) : r * (q + 1) + (xcd - r) * q) + off; }
        const int nig = WGM * nN, gid = wgid / nig, fm = gid * WGM, gsz = (nM - fm) < WGM ? (nM - fm) : WGM;
        u.pm = fm + ((wgid % nig) % gsz); u.pn = (wgid % nig) / gsz; return true;
    }
};

enum { EPI_PLAIN = 0, EPI_SWIGLU = 1, EPI_WIN = 2, EPI_PROJB = 3, EPI_PROJA = 4 };
template <int MODE> struct EpiT {
    static constexpr bool PERM = true;
    bf16_t* O; int ldc;
    bf16_t* G;
    const float* rope;
    __device__ __forceinline__ void operator()(const f32x4 (&acc)[2][2][4][2], const Unit& u, int wr, int wc, int fr, int fq) const {
        const int row0 = u.pm * BM + wr * 64 + fr;
        if constexpr (MODE == EPI_PLAIN) {
            const int col0 = u.pn * BM + wc * 32 + 8 * fq;
#pragma unroll
            for (int ai = 0; ai < 2; ++ai)
#pragma unroll
                for (int m = 0; m < 4; ++m) { bf16_t* rowp = O + (size_t)(row0 + ai * HALF + m * 16) * ldc + col0;
#pragma unroll
                    for (int bj = 0; bj < 2; ++bj) { const f32x4 v0 = acc[ai][bj][m][0], v1 = acc[ai][bj][m][1];
                        u32x4 w; w.x = cvtpk(v0[0], v0[1]); w.y = cvtpk(v0[2], v0[3]); w.z = cvtpk(v1[0], v1[1]); w.w = cvtpk(v1[2], v1[3]);
                        __builtin_nontemporal_store(w, (u32x4*)(rowp + bj * HALF)); } }
        } else if constexpr (MODE == EPI_SWIGLU) {
            const int col0 = u.pn * HALF + wc * 32 + 8 * fq;
#pragma unroll
            for (int ai = 0; ai < 2; ++ai)
#pragma unroll
                for (int m = 0; m < 4; ++m) { bf16_t* rowp = O + (size_t)(row0 + ai * HALF + m * 16) * ldc + col0;
                    float h[8];
#pragma unroll
                    for (int n = 0; n < 2; ++n)
#pragma unroll
                        for (int e = 0; e < 4; ++e) { const float g = acc[ai][0][m][n][e], uu = acc[ai][1][m][n][e]; h[4 * n + e] = g * sigmoidf_(g) * uu; }
                    u32x4 w; w.x = cvtpk(h[0], h[1]); w.y = cvtpk(h[2], h[3]); w.z = cvtpk(h[4], h[5]); w.w = cvtpk(h[6], h[7]);
                    __builtin_nontemporal_store(w, (u32x4*)rowp); }
        } else if constexpr (MODE == EPI_WIN) {
            const int pn = u.pn;
            if (pn >= 21) {
                const int col0 = (pn - 21) * BM + wc * 32 + 8 * fq;
#pragma unroll
                for (int ai = 0; ai < 2; ++ai)
#pragma unroll
                    for (int m = 0; m < 4; ++m) { bf16_t* rowp = G + (size_t)(row0 + ai * HALF + m * 16) * GP + col0;
#pragma unroll
                        for (int bj = 0; bj < 2; ++bj) { const f32x4 v0 = acc[ai][bj][m][0], v1 = acc[ai][bj][m][1];
                            u32x4 w; w.x = cvtpk(sigmoidf_(v0[0]), sigmoidf_(v0[1])); w.y = cvtpk(sigmoidf_(v0[2]), sigmoidf_(v0[3]));
                            w.z = cvtpk(sigmoidf_(v1[0]), sigmoidf_(v1[1])); w.w = cvtpk(sigmoidf_(v1[2]), sigmoidf_(v1[3]));
                            __builtin_nontemporal_store(w, (u32x4*)(rowp + bj * HALF)); } }
            } else {
                const bool isq = (pn < 4) || (pn >= 12 && pn < 15);
                const bool isrope = (pn < 8) || (pn >= 12 && pn < 18);
                const float sc = isq ? C2 : 1.f;
                const int col0 = pn * BM + wc * 32 + 8 * fq;
                const bool dorope = isrope && ((wc & 1) == 0);
                const float sgn = (fq == 0) ? -1.f : 1.f;
#pragma unroll
                for (int ai = 0; ai < 2; ++ai)
#pragma unroll
                    for (int m = 0; m < 4; ++m) { const int row = row0 + ai * HALF + m * 16; bf16_t* rowp = O + (size_t)row * ZP + col0;
                        f32x4 cs0 = {1.f, 1.f, 1.f, 1.f}, cs1 = cs0, sn0 = {0.f, 0.f, 0.f, 0.f}, sn1 = sn0;
                        if (dorope) { const f32x4* rp = (const f32x4*)(rope + (size_t)row * 16); cs0 = rp[0]; cs1 = rp[1]; sn0 = rp[2]; sn1 = rp[3]; }
#pragma unroll
                        for (int bj = 0; bj < 2; ++bj) { f32x4 v0 = acc[ai][bj][m][0], v1 = acc[ai][bj][m][1];
                            if (dorope) {
                                f32x4 o0, o1;
#pragma unroll
                                for (int e = 0; e < 4; ++e) { o0[e] = __shfl_xor(v0[e], 16); o1[e] = __shfl_xor(v1[e], 16); }
                                if (fq < 2) { v0 = v0 * cs0 + sgn * o0 * sn0; v1 = v1 * cs1 + sgn * o1 * sn1; }
                            }
                            v0 = v0 * sc; v1 = v1 * sc;
                            u32x4 w; w.x = cvtpk(v0[0], v0[1]); w.y = cvtpk(v0[2], v0[3]); w.z = cvtpk(v1[0], v1[1]); w.w = cvtpk(v1[2], v1[3]);
                            __builtin_nontemporal_store(w, (u32x4*)(rowp + bj * HALF)); } }
            }
        } else {
            const int col0 = u.pn * BM + wc * 32 + 8 * fq;
            const int gcol0 = (MODE == EPI_PROJB ? 1024 : 0) + col0;
#pragma unroll
            for (int ai = 0; ai < 2; ++ai)
#pragma unroll
                for (int m = 0; m < 4; ++m) { const int row = row0 + ai * HALF + m * 16; bf16_t* rowp = O + (size_t)row * ldc + col0; const bf16_t* gp = G + (size_t)row * GP + gcol0;
#pragma unroll
                    for (int bj = 0; bj < 2; ++bj) { const f32x4 v0 = acc[ai][bj][m][0], v1 = acc[ai][bj][m][1];
                        const u32x4 gw = *(const u32x4*)(gp + bj * HALF);
                        float r[8];
                        r[0] = bflo(gw.x) * v0[0]; r[1] = bfhi(gw.x) * v0[1]; r[2] = bflo(gw.y) * v0[2]; r[3] = bfhi(gw.y) * v0[3];
                        r[4] = bflo(gw.z) * v1[0]; r[5] = bfhi(gw.z) * v1[1]; r[6] = bflo(gw.w) * v1[2]; r[7] = bfhi(gw.w) * v1[3];
                        if constexpr (MODE == EPI_PROJA) { const u32x4 pw = *(const u32x4*)(rowp + bj * HALF);
                            r[0] += bflo(pw.x); r[1] += bfhi(pw.x); r[2] += bflo(pw.y); r[3] += bfhi(pw.y); r[4] += bflo(pw.z); r[5] += bfhi(pw.z); r[6] += bflo(pw.w); r[7] += bfhi(pw.w); }
                        u32x4 w; w.x = cvtpk(r[0], r[1]); w.y = cvtpk(r[2], r[3]); w.z = cvtpk(r[4], r[5]); w.w = cvtpk(r[6], r[7]);
                        *(u32x4*)(rowp + bj * HALF) = w; }
                    asm volatile("" ::: "memory"); }
        }
    }
};

template <class Epi, bool ALIGN_EPI>
__device__ __forceinline__ void gemm_phase(LAS unsigned char* lds, const Gemm g, const StaticOrder& S, const Epi& E) {
    const int tid = threadIdx.x, wid = __builtin_amdgcn_readfirstlane(tid >> 6), lane = tid & 63, wr = wid >> 2, wc = wid & 3, fr = lane & 15, fq = lane >> 4;
    const int K = g.K, nt = K / BK, lda = g.lda;
    unsigned voffA[2], voffB[2];
#pragma unroll
    for (int i = 0; i < 2; ++i) { int R, C; stage_rc(tid * 16 + i * 8192, R, C); const int Rb = Epi::PERM ? ((R & ~31) + perm32(R & 31)) : R;
        voffA[i] = (unsigned)(R * lda + C) * 2u; voffB[i] = (unsigned)(Rb * K + C) * 2u; }
    const size_t kstep = (size_t)(BK * 2);
    const size_t hstepA = (size_t)HALF * lda * 2, hstepB = (size_t)HALF * K * 2;
    const size_t tstepA = 2 * hstepA, tstepB = 2 * hstepB;
    const unsigned ldsw = (unsigned)wid * 1024u;
    const int aoff = lds_byte(wr * 64 + fr, fq * 8), boff = lds_byte(wc * 32 + fr, fq * 8);
#define PG8_SA(b, h) (((b) * 2 + (h)) * HTB)
#define PG8_SB(b, h) ((4 + (b) * 2 + (h)) * HTB)
#define PG8_STAGE(bufoff, gbase, voff) do { _Pragma("unroll") for (int _i = 0; _i < 2; ++_i) \
        __builtin_amdgcn_global_load_lds((const unsigned*)((const char*)(gbase) + (voff)[_i]), (LAS unsigned*)(lds + (bufoff) + ldsw + _i * 8192), 16, 0, 0); } while (0)
#define PG8_LDA(dst, b, h) do { _Pragma("unroll") for (int m = 0; m < 4; ++m) _Pragma("unroll") for (int k = 0; k < 2; ++k) dst[m][k] = *(const LAS bf16x8*)(lds + PG8_SA(b, h) + aoff + m * 2048 + k * 1024); } while (0)
#define PG8_LDB(dst, b, h) do { _Pragma("unroll") for (int n = 0; n < 2; ++n) _Pragma("unroll") for (int k = 0; k < 2; ++k) dst[n][k] = *(const LAS bf16x8*)(lds + PG8_SB(b, h) + boff + n * 2048 + k * 1024); } while (0)
#define PG8_MMA(ai, bj, At, Bt) do { __builtin_amdgcn_s_setprio(1); _Pragma("unroll") for (int m = 0; m < 4; ++m) _Pragma("unroll") for (int n = 0; n < 2; ++n) _Pragma("unroll") for (int k = 0; k < 2; ++k) \
        acc[ai][bj][m][n] = __builtin_amdgcn_mfma_f32_16x16x32_bf16(Bt[n][k], At[m][k], acc[ai][bj][m][n], 0, 0, 0); __builtin_amdgcn_s_setprio(0); } while (0)
#define PG8_WAIT_V(n) asm volatile("s_waitcnt vmcnt(" #n ")" ::: "memory")
#define PG8_WAIT_L(n) asm volatile("s_waitcnt lgkmcnt(" #n ")" ::: "memory")
#define PG8_BAR __builtin_amdgcn_s_barrier()
#define PG8_SCHED __builtin_amdgcn_sched_barrier(0)
    Unit cur, nxt; int ui = 0;
    if (!S.next(0, cur)) return;
    f32x4 acc[2][2][4][2];
#pragma unroll
    for (int a = 0; a < 2; ++a)
#pragma unroll
        for (int b = 0; b < 2; ++b)
#pragma unroll
            for (int m = 0; m < 4; ++m)
#pragma unroll
                for (int n = 0; n < 2; ++n) acc[a][b][m][n] = (f32x4){0.f, 0.f, 0.f, 0.f};
    bf16x8 At[4][2], B0[2][2], B1[2][2];
    const char* cA = (const char*)g.A + (size_t)cur.pm * tstepA; const char* cB = (const char*)g.Bt + (size_t)cur.pn * tstepB;
    PG8_STAGE(PG8_SB(0, 0), cB, voffB); PG8_STAGE(PG8_SB(0, 1), cB + hstepB, voffB); PG8_STAGE(PG8_SA(0, 0), cA, voffA); PG8_STAGE(PG8_SA(0, 1), cA + hstepA, voffA);
    if (wr == 1) PG8_BAR;
    PG8_WAIT_V(2); PG8_BAR;
    PG8_STAGE(PG8_SB(1, 0), cB + kstep, voffB); PG8_STAGE(PG8_SA(1, 0), cA + kstep, voffA); PG8_STAGE(PG8_SB(1, 1), cB + hstepB + kstep, voffB);
    PG8_WAIT_V(6); PG8_BAR;
    for (;;) {
        const bool has_next = S.next(ui + 1, nxt);
        const char* nA = has_next ? (const char*)g.A + (size_t)nxt.pm * tstepA : cA; const char* nB = has_next ? (const char*)g.Bt + (size_t)nxt.pn * tstepB : cB;
        for (int t = 0; t < nt; t += 2) {
            const bool last = (t == nt - 2);
            const char* a1 = cA + (size_t)(t + 1) * kstep;
            const char* a2 = last ? nA : cA + (size_t)(t + 2) * kstep; const char* b2 = last ? nB : cB + (size_t)(t + 2) * kstep;
            const char* a3 = a2 + kstep; const char* b3 = b2 + kstep;
            PG8_LDB(B0, 0, 0); PG8_LDB(B1, 0, 1); PG8_SCHED; PG8_LDA(At, 0, 0); PG8_STAGE(PG8_SA(1, 1), a1 + hstepA, voffA);
            PG8_WAIT_V(8); PG8_WAIT_L(0); PG8_BAR; PG8_MMA(0, 0, At, B0); PG8_MMA(0, 1, At, B1); PG8_BAR; PG8_SCHED;
            PG8_LDA(At, 0, 1); PG8_STAGE(PG8_SB(0, 0), b2, voffB); PG8_STAGE(PG8_SB(0, 1), b2 + hstepB, voffB); PG8_STAGE(PG8_SA(0, 0), a2, voffA);
            PG8_WAIT_V(8); PG8_WAIT_L(0); PG8_BAR; PG8_MMA(1, 0, At, B0); PG8_MMA(1, 1, At, B1); PG8_BAR; PG8_SCHED;
            PG8_LDB(B0, 1, 0); PG8_LDB(B1, 1, 1); PG8_SCHED; PG8_LDA(At, 1, 0); PG8_STAGE(PG8_SA(0, 1), a2 + hstepA, voffA);
            PG8_WAIT_V(8); PG8_WAIT_L(0); PG8_BAR; PG8_MMA(0, 0, At, B0); PG8_MMA(0, 1, At, B1); PG8_BAR; PG8_SCHED;
            PG8_LDA(At, 1, 1); PG8_STAGE(PG8_SB(1, 0), b3, voffB); PG8_STAGE(PG8_SB(1, 1), b3 + hstepB, voffB); PG8_STAGE(PG8_SA(1, 0), a3, voffA);
            PG8_WAIT_V(8); PG8_WAIT_L(0); PG8_BAR; PG8_MMA(1, 0, At, B0); PG8_MMA(1, 1, At, B1); PG8_BAR; PG8_SCHED;
        }
        if constexpr (ALIGN_EPI) { if (wr == 0) PG8_BAR; }
        E(acc, cur, wr, wc, fr, fq);
        if (!has_next) break;
#pragma unroll
        for (int a = 0; a < 2; ++a)
#pragma unroll
            for (int b = 0; b < 2; ++b)
#pragma unroll
                for (int m = 0; m < 4; ++m)
#pragma unroll
                    for (int n = 0; n < 2; ++n) acc[a][b][m][n] = (f32x4){0.f, 0.f, 0.f, 0.f};
        cur = nxt; cA = nA; cB = nB; ++ui;
        if constexpr (ALIGN_EPI) { if (wr == 1) PG8_BAR; }
    }
    PG8_WAIT_V(0);
    if constexpr (!ALIGN_EPI) { if (wr == 0) PG8_BAR; }
    PG8_BAR;
#undef PG8_SA
#undef PG8_SB
#undef PG8_STAGE
#undef PG8_LDA
#undef PG8_LDB
#undef PG8_MMA
#undef PG8_WAIT_V
#undef PG8_WAIT_L
#undef PG8_BAR
#undef PG8_SCHED
}
}

struct Args { const float* in[21]; float* out; unsigned char* ws; int ph_lo, ph_hi; };
enum { IN_X = 0, IN_POS, IN_WIN, IN_LQ1, IN_LK1, IN_LQ2, IN_LK2, IN_GSUB, IN_WPA, IN_WPB, IN_WOUT, IN_WGU1, IN_WD1, IN_WGU2, IN_WD2, IN_GPRE1, IN_GPOST1, IN_GPREM, IN_GPOSTM, IN_GPRE2, IN_GPOST2 };
typedef const __attribute__((address_space(4))) Args* kargs_t;
__device__ __forceinline__ constexpr int crow(int r, int hi) { return (r & 3) + 8 * (r >> 2) + 4 * hi; }
__device__ __forceinline__ s16x4 vtr(const LAS unsigned char* p) {
    typedef short v4i16_t __attribute__((ext_vector_type(4)));
    return __builtin_bit_cast(s16x4, __builtin_amdgcn_ds_read_tr16_b64_v4i16((LAS v4i16_t*)p));
}
__device__ __forceinline__ float max3f(float a, float b, float c) { float r; asm("v_max3_f32 %0, %1, %2, %3" : "=v"(r) : "v"(a), "v"(b), "v"(c)); return r; }
__device__ __forceinline__ float max2f(float a, float b) { float r; asm("v_max_f32_e32 %0, %1, %2" : "=v"(r) : "v"(a), "v"(b)); return r; }
__device__ __forceinline__ float rowmax32(const f32x16& p0, const f32x16& p1) {
    float a = max3f(p0[0], p0[1], p1[0]), b = max3f(p0[2], p0[3], p1[1]); a = max3f(a, p1[2], p1[3]);
#pragma unroll
    for (int r = 4; r < 16; r += 4) { a = max3f(a, p0[r], p0[r + 1]); b = max3f(b, p0[r + 2], p0[r + 3]); a = max3f(a, p1[r], p1[r + 1]); b = max3f(b, p1[r + 2], p1[r + 3]); }
    a = max2f(a, b);
    auto rr = __builtin_amdgcn_permlane32_swap(__float_as_uint(a), __float_as_uint(a), false, false);
    return max2f(__uint_as_float(rr[0]), __uint_as_float(rr[1]));
}
__device__ __forceinline__ float halfmax(float a) {
    auto rr = __builtin_amdgcn_permlane32_swap(__float_as_uint(a), __float_as_uint(a), false, false);
    return max2f(__uint_as_float(rr[0]), __uint_as_float(rr[1]));
}
__device__ __forceinline__ float halfsum(float x) {
    auto rr = __builtin_amdgcn_permlane32_swap(__float_as_uint(x), __float_as_uint(x), false, false);
    return __uint_as_float(rr[0]) + __uint_as_float(rr[1]);
}
#define GLDS16(gsrc, ldsdst) __builtin_amdgcn_global_load_lds((const unsigned*)(gsrc), (LAS unsigned*)(ldsdst), 16, 0, 0)
__device__ __forceinline__ void glds16_asm(const void* gsrc, unsigned lds_dst) {
    unsigned keep;
    asm volatile("s_mov_b32 %0, m0\n\ts_mov_b32 m0, %2\n\ts_nop 0\n\tglobal_load_lds_dwordx4 %1, off\n\ts_mov_b32 m0, %0" : "=&s"(keep) : "v"(gsrc), "s"(lds_dst) : "memory");
}
#define GLDS16A(gsrc, ldsdst) glds16_asm((const void*)(gsrc), (unsigned)__builtin_amdgcn_readfirstlane((int)(unsigned)(uintptr_t)(ldsdst)))
#define WAIT_VM0_BAR() do { asm volatile("s_waitcnt vmcnt(0)" ::: "memory"); __builtin_amdgcn_s_barrier(); asm volatile("" ::: "memory"); } while (0)

template <int THR>
__device__ __forceinline__ bool softmax_tile(f32x16& p0, f32x16& p1, float& m_run, float& l_run, LAS float* wsf, int r32, int hi) {
    const float rm = rowmax32(p0, p1);
    const bool resc = __any(rm > m_run + (float)THR);
    if (resc) {
        const float mn = max2f(m_run, rm); const float f = fast_exp2(m_run - mn); m_run = mn; l_run *= f;
        if (hi == 0) wsf[r32] = f;
    }
    const float mm = m_run; float s = 0.f;
#pragma unroll
    for (int r = 0; r < 16; ++r) { p0[r] = fast_exp2(p0[r] - mm); p1[r] = fast_exp2(p1[r] - mm); s += p0[r] + p1[r]; }
    l_run += s;
    return resc;
}
template <int THR>
__device__ __forceinline__ bool softmax_rel(f32x16& p0, f32x16& p1, float& m_run, float& l_run, bool first, LAS float* wsf, int r32, int hi) {
    const float rm = rowmax32(p0, p1);
    const bool resc = first || __any(rm > (float)THR);
    if (resc) {
        const float dl = first ? rm : fmaxf(rm, 0.f); m_run += dl;
        const float f = first ? 0.f : fast_exp2(-dl); l_run *= f;
        if (hi == 0) wsf[r32] = f;
#pragma unroll
        for (int r = 0; r < 16; ++r) { p0[r] -= dl; p1[r] -= dl; }
    }
    float s = 0.f;
#pragma unroll
    for (int r = 0; r < 16; ++r) { p0[r] = fast_exp2(p0[r]); p1[r] = fast_exp2(p1[r]); s += p0[r] + p1[r]; }
    l_run += s;
    return resc;
}
__device__ __forceinline__ bf16x8 pack8(const f32x16& p, int b) {
    u32x4 w; w.x = cvtpk(p[b], p[b + 1]); w.y = cvtpk(p[b + 2], p[b + 3]); w.z = cvtpk(p[b + 4], p[b + 5]); w.w = cvtpk(p[b + 6], p[b + 7]);
    return __builtin_bit_cast(bf16x8, w);
}
#define MFMA32(a, b, c) __builtin_amdgcn_mfma_f32_32x32x16_bf16((a), (b), (c), 0, 0, 0)

template <int THR>
__device__ __forceinline__ void diff_unit(int b, int h, int qb, bf16_t* Z, const float* gsub, float lam, LAS unsigned char* lds) {
    const int tid = threadIdx.x; int lane_ = tid & 63; asm volatile("" : "+v"(lane_));
    const int lane = lane_, r32 = lane & 31, hi = lane >> 5;
    const int w = __builtin_amdgcn_readfirstlane(tid >> 6);
    const size_t rowbase = (size_t)b * SEQ;
    const int q0 = qb * 256 + w * 32;
    LAS unsigned char* Qw = lds + 67584 + w * 8704;
    { const bf16_t* qg = Z + (rowbase + q0) * ZP + h * 128;
      int l0 = threadIdx.x & 63; asm volatile("" : "+v"(l0));
      const unsigned goff = (unsigned)((l0 >> 4) * ZP + (l0 & 15) * 8), loff = (unsigned)((l0 >> 4) * 272 + (l0 & 15) * 16);
      const bf16_t* qgl = qg + goff; LAS unsigned char* qwl = Qw + loff;
#pragma unroll 1
      for (int j = 0; j < 8; ++j) { *(LAS u32x4*)qwl = *(const u32x4*)qgl; qgl += 4 * ZP; qwl += 4 * 272; } }
    const LAS unsigned char* qrd = Qw + r32 * 272 + hi * 16;
    const int krow = 8 * w + (lane >> 3);
    const bf16_t* kbase = Z + rowbase * ZP + ZC_KA + h * 128;
    const bf16_t* vbase = Z + rowbase * ZP + ZC_VA + h * 128;
    const unsigned koff = (unsigned)(krow * ZP + (((lane & 7) ^ ((krow >> 1) & 7)) << 3));
    const unsigned voff = (unsigned)((4 * w + (lane >> 4)) * ZP + (((lane & 15) ^ (((lane >> 4) & 3) << 2)) << 3));
    const unsigned wl = (unsigned)w * 1024u;
#define DIFF_ISSUE(t, buf) do { const bf16_t* _k = kbase + (size_t)(t) * 64 * ZP; const bf16_t* _v = vbase + (size_t)(t) * 64 * ZP; LAS unsigned char* _b = lds + (buf) * 32768; \
        GLDS16(_k + koff, _b + wl); GLDS16(_k + 64 + koff, _b + 8192 + wl); GLDS16(_v + voff, _b + 16384 + wl); GLDS16(_v + (size_t)32 * ZP + voff, _b + 16384 + 8192 + wl); } while (0)
    const int swz = (r32 >> 1) & 7;
    int kaddr[4];
#pragma unroll
    for (int d0 = 0; d0 < 4; ++d0) kaddr[d0] = r32 * 128 + (((2 * d0 + hi) ^ swz) << 4);
    const int q4 = (lane >> 2) & 3, gb = (lane >> 4) & 1, p4 = lane & 3;
    int vaddr[4];
#pragma unroll
    for (int d = 0; d < 4; ++d) vaddr[d] = (4 * hi + q4) * 256 + ((d ^ q4) << 6) + 32 * gb + 8 * p4;
    LAS float* wsf = (LAS float*)(lds + 65536) + w * 64;

    float m_init = 0.f; asm volatile("" : "+v"(m_init));
    float m_run[2] = {m_init, m_init}, l_run[2] = {0.f, 0.f};
    f32x16 o[2][4];
#pragma unroll
    for (int c = 0; c < 2; ++c)
#pragma unroll
        for (int d = 0; d < 4; ++d)
#pragma unroll
            for (int r = 0; r < 16; ++r) o[c][d][r] = 0.f;
    constexpr int NT = SEQ / 64;
    DIFF_ISSUE(0, 0);
    if (w >= 4) __builtin_amdgcn_s_setprio(1);
    for (int t = 0; t < NT; ++t) {
        WAIT_VM0_BAR();
        if (t + 1 < NT) DIFF_ISSUE(t + 1, (t + 1) & 1);
        const LAS unsigned char* B = lds + (t & 1) * 32768;
        bf16x8 pa[2][4]; bool resc[2];
#pragma unroll
        for (int c = 0; c < 2; ++c) {
            f32x16 p0, p1, negm;
            { const float nm = -m_run[c];
#pragma unroll
              for (int r = 0; r < 16; ++r) negm[r] = nm; }
#pragma unroll
            for (int d0 = 0; d0 < 4; ++d0) {
                const bf16x8 k0 = *(const LAS bf16x8*)(B + c * 8192 + kaddr[d0]);
                const bf16x8 k1 = *(const LAS bf16x8*)(B + c * 8192 + 4096 + kaddr[d0]);
                const bf16x8 qv = *(const LAS bf16x8*)(qrd + c * 128 + d0 * 32);
                if (d0 == 0) { p0 = MFMA32(k0, qv, negm); p1 = MFMA32(k1, qv, negm); } else { p0 = MFMA32(k0, qv, p0); p1 = MFMA32(k1, qv, p1); }
                asm volatile("" ::: "memory");
            }
            resc[c] = softmax_rel<THR>(p0, p1, m_run[c], l_run[c], t == 0, wsf + c * 32, r32, hi);
            pa[c][0] = pack8(p0, 0); pa[c][1] = pack8(p0, 8); pa[c][2] = pack8(p1, 0); pa[c][3] = pack8(p1, 8);
        }
#pragma unroll
        for (int c = 0; c < 2; ++c)
            if (resc[c]) {
#pragma unroll
                for (int r = 0; r < 16; ++r) { const float f = wsf[c * 32 + crow(r, hi)];
#pragma unroll
                    for (int d = 0; d < 4; ++d) o[c][d][r] *= f; }
            }
#pragma unroll
        for (int s = 0; s < 4; ++s)
#pragma unroll
            for (int d = 0; d < 4; ++d) {
                const s16x4 lo = vtr(B + 16384 + vaddr[d] + s * 4096), hi4 = vtr(B + 16384 + vaddr[d] + s * 4096 + 2048);
                const bf16x8 vf = (bf16x8){lo[0], lo[1], lo[2], lo[3], hi4[0], hi4[1], hi4[2], hi4[3]};
                o[0][d] = MFMA32(pa[0][s], vf, o[0][d]); o[1][d] = MFMA32(pa[1][s], vf, o[1][d]);
                if (d & 1) asm volatile("" ::: "memory");
            }
    }
#undef DIFF_ISSUE
    __builtin_amdgcn_s_setprio(0);
    { const float l0 = halfsum(l_run[0]), l1 = halfsum(l_run[1]);
      if (hi == 0) { wsf[r32] = fast_rcp(l0); wsf[32 + r32] = lam * fast_rcp(l1); } }
    int le = threadIdx.x & 63; asm volatile("" : "+v"(le));
    const int r32e = le & 31, hie = le >> 5;
    const LAS float* wse = (const LAS float*)(lds + 65536) + w * 64 + 4 * hie;
    float gs[4];
#pragma unroll
    for (int d = 0; d < 4; ++d) gs[d] = gsub[d * 32 + r32e] * (1.f - LAMBDA_INIT);
    bf16_t* op = Z + (rowbase + q0) * ZP + h * 128;
    const unsigned ooff = (unsigned)(4 * hie * ZP + r32e);
#pragma unroll
    for (int r = 0; r < 16; ++r) {
        const int qc = (r & 3) + 8 * (r >> 2); const float i1 = wse[qc], i2 = wse[32 + qc];
        float v[4]; float ss = 0.f;
#pragma unroll
        for (int d = 0; d < 4; ++d) { v[d] = o[0][d][r] * i1 - o[1][d][r] * i2; ss += v[d] * v[d]; }
        ss += __shfl_xor(ss, 1); ss += __shfl_xor(ss, 2); ss += __shfl_xor(ss, 4); ss += __shfl_xor(ss, 8); ss += __shfl_xor(ss, 16);
        const float rstd = 1.0f / sqrtf(ss * (1.f / 128.f) + EPS);
#pragma unroll
        for (int d = 0; d < 4; ++d) { const unsigned pk = cvtpk(v[d] * rstd * gs[d], 0.f); op[ooff + (unsigned)(qc * ZP + d * 32)] = (bf16_t)(pk & 0xffffu); }
    }
}

template <int DIL>
__device__ __forceinline__ void dil_group(int g, size_t rowbase, int hg, int qb, const bf16_t* Z, LAS unsigned char* lds, float& m_run, float& l_run, f32x16 (&o)[2],
                                          int lane, int r32, int hi, int w, LAS float* wsf) {
    const int head = 4 * g + hg;
    const int blk = qb * 256, tq = blk + 16 * (r32 >> 1) + 2 * w + (r32 & 1);
    bf16x8 qf[4];
    { const bf16_t* qp = Z + (rowbase + tq) * ZP + ZC_QD + head * 64 + hi * 8;
#pragma unroll
      for (int d0 = 0; d0 < 4; ++d0) qf[d0] = *(const bf16x8*)(qp + d0 * 16); }
    f32x16 am;
#pragma unroll
    for (int r = 0; r < 16; ++r) am[r] = ((((r & 3) + 8 * (r >> 2) + 4 * hi - tq) & (DIL - 1)) == 0) ? 0.f : -INFINITY;
    int kstart = qb * 256 - 64 * DIL; if (kstart < 0) kstart = 0;
    int kend = qb * 256 + 256 + 64 * DIL; if (kend > SEQ) kend = SEQ;
    const int NT = (kend - kstart) >> 6;
    const int krow = 8 * w + (lane >> 3);
    const bf16_t* ksrc = Z + (rowbase + kstart + krow) * ZP + ZC_KD + head * 64 + (((lane & 7) ^ ((krow >> 1) & 7)) << 3);
    const bf16_t* vsrc = Z + (rowbase + kstart + krow) * ZP + ZC_VD + head * 64 + (((lane & 7) ^ (((krow >> 1) & 1) << 2)) << 3);
    const unsigned wl = (unsigned)w * 1024u;
#define DIL_ISSUE(t, buf) do { const size_t _o = (size_t)(t) * 64 * ZP; LAS unsigned char* _b = lds + (buf) * 16384; GLDS16(ksrc + _o, _b + wl); GLDS16(vsrc + _o, _b + 8192 + wl); } while (0)
    const int swz = (r32 >> 1) & 7;
    int kaddr[4];
#pragma unroll
    for (int d0 = 0; d0 < 4; ++d0) kaddr[d0] = r32 * 128 + (((2 * d0 + hi) ^ swz) << 4);
    const int q4 = (lane >> 2) & 3, gb = (lane >> 4) & 1, p4 = lane & 3;
    int vaddr[2];
#pragma unroll
    for (int d = 0; d < 2; ++d) vaddr[d] = (4 * hi + q4) * 128 + ((d ^ (q4 >> 1)) << 6) + 32 * gb + 8 * p4;
    __syncthreads();
    asm volatile("s_waitcnt vmcnt(0)" ::: "memory");
#pragma unroll
    for (int i = 0; i < 6; ++i) if (i < NT) DIL_ISSUE(i, i);
    for (int t = 0; t < NT; ++t) {
        { const int rem = NT - 1 - t;
          if (rem >= 5) asm volatile("s_waitcnt vmcnt(10)" ::: "memory"); else if (rem == 4) asm volatile("s_waitcnt vmcnt(8)" ::: "memory");
          else if (rem == 3) asm volatile("s_waitcnt vmcnt(6)" ::: "memory"); else if (rem == 2) asm volatile("s_waitcnt vmcnt(4)" ::: "memory");
          else if (rem == 1) asm volatile("s_waitcnt vmcnt(2)" ::: "memory"); else asm volatile("s_waitcnt vmcnt(0)" ::: "memory"); }
        __builtin_amdgcn_s_barrier(); asm volatile("" ::: "memory");
        if (t + 6 < NT) DIL_ISSUE(t + 6, (t + 6) & 7);
        const int k0 = kstart + t * 64;
        {
            const LAS unsigned char* B = lds + (t & 7) * 16384;
            f32x16 p0, p1;
#pragma unroll
            for (int d0 = 0; d0 < 4; ++d0) {
                const bf16x8 ka = *(const LAS bf16x8*)(B + kaddr[d0]);
                const bf16x8 kb = *(const LAS bf16x8*)(B + 4096 + kaddr[d0]);
                if (d0 == 0) { p0 = MFMA32(ka, qf[d0], am); p1 = MFMA32(kb, qf[d0], am); }
                else { p0 = MFMA32(ka, qf[d0], p0); p1 = MFMA32(kb, qf[d0], p1); }
            }
            const bool interior = (k0 + 63 - blk <= 64 * DIL) && (blk + 255 - k0 <= 64 * DIL);
            if (!interior) {
                const int dd = k0 + 4 * hi - tq;
#pragma unroll
                for (int r = 0; r < 16; ++r) {
                    const int d0_ = dd + (r & 3) + 8 * (r >> 2), d1_ = d0_ + 32;
                    const bool v0 = (d0_ <= 64 * DIL) && (d0_ >= -64 * DIL);
                    const bool v1 = (d1_ <= 64 * DIL) && (d1_ >= -64 * DIL);
                    p0[r] = v0 ? p0[r] : -INFINITY; p1[r] = v1 ? p1[r] : -INFINITY;
                }
            }
            const bool resc = softmax_tile<8>(p0, p1, m_run, l_run, wsf, r32, hi);
            const bf16x8 pa0 = pack8(p0, 0), pa1 = pack8(p0, 8), pa2 = pack8(p1, 0), pa3 = pack8(p1, 8);
            if (resc) {
#pragma unroll
                for (int r = 0; r < 16; ++r) { const float f = wsf[crow(r, hi)]; o[0][r] *= f; o[1][r] *= f; }
            }
#pragma unroll
            for (int d = 0; d < 2; ++d) {
                const LAS unsigned char* vb = B + 8192 + vaddr[d];
                s16x4 lo, h4; bf16x8 vf;
                lo = vtr(vb + 0 * 2048); h4 = vtr(vb + 0 * 2048 + 1024); vf = (bf16x8){lo[0], lo[1], lo[2], lo[3], h4[0], h4[1], h4[2], h4[3]}; o[d] = MFMA32(pa0, vf, o[d]);
                lo = vtr(vb + 1 * 2048); h4 = vtr(vb + 1 * 2048 + 1024); vf = (bf16x8){lo[0], lo[1], lo[2], lo[3], h4[0], h4[1], h4[2], h4[3]}; o[d] = MFMA32(pa1, vf, o[d]);
                lo = vtr(vb + 2 * 2048); h4 = vtr(vb + 2 * 2048 + 1024); vf = (bf16x8){lo[0], lo[1], lo[2], lo[3], h4[0], h4[1], h4[2], h4[3]}; o[d] = MFMA32(pa2, vf, o[d]);
                lo = vtr(vb + 3 * 2048); h4 = vtr(vb + 3 * 2048 + 1024); vf = (bf16x8){lo[0], lo[1], lo[2], lo[3], h4[0], h4[1], h4[2], h4[3]}; o[d] = MFMA32(pa3, vf, o[d]);
            }
        }
    }
#undef DIL_ISSUE
}
__device__ __forceinline__ void dil_group4(size_t rowbase, int hg, int qb, const bf16_t* Z, LAS unsigned char* lds, float& m_run, float& l_run, f32x16 (&o)[2],
                                           int lane, int r32, int hi, int w, LAS float* wsf) {
    const int head = 4 + hg;
    const int blk = qb * 256, tq = blk + 16 * (r32 >> 1) + 2 * w + (r32 & 1);
    bf16x8 qf[4];
    { const bf16_t* qp = Z + (rowbase + tq) * ZP + ZC_QD + head * 64 + hi * 8;
#pragma unroll
      for (int d0 = 0; d0 < 4; ++d0) qf[d0] = *(const bf16x8*)(qp + d0 * 16); }
    f32x16 am;
#pragma unroll
    for (int r = 0; r < 16; ++r) am[r] = (((r ^ r32) & 1) == 0) ? 0.f : -INFINITY;
    int kstart = blk - 256; if (kstart < 0) kstart = 0;
    int kend = blk + 512; if (kend > SEQ) kend = SEQ;
    const int NST = (kend - kstart) >> 7;
    const int X = w & 1;
    const int kkl = 8 * w + (lane >> 3);
    const int tokoff = 4 * (kkl >> 1) + (kkl & 1);
    const bf16_t* kbase = Z + (rowbase + kstart + tokoff) * ZP + ZC_KD + head * 64 + (((lane & 7) ^ ((kkl >> 1) & 7)) << 3);
    const bf16_t* vbase = Z + (rowbase + kstart + tokoff) * ZP + ZC_VD + head * 64 + (((lane & 7) ^ (((kkl >> 1) & 1) << 2)) << 3);
    const unsigned wl = (unsigned)w * 1024u;
#define D4_ISSUE(st, slot) do { const size_t _o = (size_t)(st) * 128 * ZP; LAS unsigned char* _b = lds + (slot) * 32768; \
        GLDS16A(kbase + _o, _b + wl); GLDS16A(vbase + _o, _b + 8192 + wl); \
        GLDS16A(kbase + _o + (size_t)2 * ZP, _b + 16384 + wl); GLDS16A(vbase + _o + (size_t)2 * ZP, _b + 16384 + 8192 + wl); } while (0)
    const int swz = (r32 >> 1) & 7;
    int kaddr[4];
#pragma unroll
    for (int d0 = 0; d0 < 4; ++d0) kaddr[d0] = r32 * 128 + (((2 * d0 + hi) ^ swz) << 4);
    const int q4 = (lane >> 2) & 3, gb = (lane >> 4) & 1, p4 = lane & 3;
    int vaddr[2];
#pragma unroll
    for (int d = 0; d < 2; ++d) vaddr[d] = (4 * hi + q4) * 128 + ((d ^ (q4 >> 1)) << 6) + 32 * gb + 8 * p4;
    __syncthreads();
    asm volatile("s_waitcnt vmcnt(0)" ::: "memory");
#pragma unroll
    for (int i = 0; i < 3; ++i) if (i < NST) D4_ISSUE(i, i);
    for (int st = 0; st < NST; ++st) {
        { const int rem = NST - 1 - st;
          if (rem >= 2) asm volatile("s_waitcnt vmcnt(8)" ::: "memory"); else if (rem == 1) asm volatile("s_waitcnt vmcnt(4)" ::: "memory"); else asm volatile("s_waitcnt vmcnt(0)" ::: "memory"); }
        __builtin_amdgcn_s_barrier(); asm volatile("" ::: "memory");
        if (st + 3 < NST) D4_ISSUE(st + 3, (st + 3) & 3);
        const LAS unsigned char* B = lds + (st & 3) * 32768 + X * 16384;
        const int dT = kstart + st * 128 - blk;
        f32x16 p0, p1;
#pragma unroll
        for (int d0 = 0; d0 < 4; ++d0) {
            const bf16x8 ka = *(const LAS bf16x8*)(B + kaddr[d0]);
            const bf16x8 kb = *(const LAS bf16x8*)(B + 4096 + kaddr[d0]);
            if (d0 == 0) { p0 = MFMA32(ka, qf[d0], am); p1 = MFMA32(kb, qf[d0], am); }
            else { p0 = MFMA32(ka, qf[d0], p0); p1 = MFMA32(kb, qf[d0], p1); }
        }
        if (dT < -2 || dT > 132) {
            const int dd = dT - 16 * (r32 >> 1) + 2 * X - 2 * w;
#pragma unroll
            for (int r = 0; r < 16; ++r) { const int kk = (r & 3) + 8 * (r >> 2) + 4 * hi; const int d0_ = dd + 4 * (kk >> 1), d1_ = d0_ + 64;
                p0[r] = (d0_ <= 256 && d0_ >= -256) ? p0[r] : -INFINITY; p1[r] = (d1_ <= 256 && d1_ >= -256) ? p1[r] : -INFINITY; }
        }
        const bool resc = softmax_tile<8>(p0, p1, m_run, l_run, wsf, r32, hi);
        const bf16x8 pa0 = pack8(p0, 0), pa1 = pack8(p0, 8), pa2 = pack8(p1, 0), pa3 = pack8(p1, 8);
        if (resc) {
#pragma unroll
            for (int r = 0; r < 16; ++r) { const float f = wsf[crow(r, hi)]; o[0][r] *= f; o[1][r] *= f; }
        }
#pragma unroll
        for (int d = 0; d < 2; ++d) {
            const LAS unsigned char* vb = B + 8192 + vaddr[d];
            s16x4 lo, h4; bf16x8 vf;
            lo = vtr(vb + 0 * 2048); h4 = vtr(vb + 0 * 2048 + 1024); vf = (bf16x8){lo[0], lo[1], lo[2], lo[3], h4[0], h4[1], h4[2], h4[3]}; o[d] = MFMA32(pa0, vf, o[d]);
            lo = vtr(vb + 1 * 2048); h4 = vtr(vb + 1 * 2048 + 1024); vf = (bf16x8){lo[0], lo[1], lo[2], lo[3], h4[0], h4[1], h4[2], h4[3]}; o[d] = MFMA32(pa1, vf, o[d]);
            lo = vtr(vb + 2 * 2048); h4 = vtr(vb + 2 * 2048 + 1024); vf = (bf16x8){lo[0], lo[1], lo[2], lo[3], h4[0], h4[1], h4[2], h4[3]}; o[d] = MFMA32(pa2, vf, o[d]);
            lo = vtr(vb + 3 * 2048); h4 = vtr(vb + 3 * 2048 + 1024); vf = (bf16x8){lo[0], lo[1], lo[2], lo[3], h4[0], h4[1], h4[2], h4[3]}; o[d] = MFMA32(pa3, vf, o[d]);
        }
    }
#undef D4_ISSUE
}
__device__ __forceinline__ void dil_group16(size_t rowbase, int hg, int qb, const bf16_t* Z, LAS unsigned char* lds, float& m_run, float& l_run, f32x16 (&o)[2],
                                            int lane, int r32, int hi, int w, LAS float* wsf) {
    const int head = 8 + hg;
    const int blk = qb * 256, tq = blk + 16 * (r32 >> 1) + 2 * w + (r32 & 1);
    bf16x8 qf[4];
    { const bf16_t* qp = Z + (rowbase + tq) * ZP + ZC_QD + head * 64 + hi * 8;
#pragma unroll
      for (int d0 = 0; d0 < 4; ++d0) qf[d0] = *(const bf16x8*)(qp + d0 * 16); }
    f32x16 am;
#pragma unroll
    for (int r = 0; r < 16; ++r) am[r] = (((r ^ r32) & 1) == 0) ? 0.f : -INFINITY;
    int kstart = blk - 1024; if (kstart < 0) kstart = 0;
    int kend = blk + 256 + 1024; if (kend > SEQ) kend = SEQ;
    const int NST = (kend - kstart) >> 8;
    const int i4 = lane >> 4;
    const int rowoff = 16 * i4 + 2 * w + ((lane >> 3) & 1);
    const int kch = (lane & 7) ^ i4;
    const bf16_t* kbase = Z + (rowbase + kstart + rowoff) * ZP + ZC_KD + head * 64;
    const bf16_t* vbase = Z + (rowbase + kstart + rowoff) * ZP + ZC_VD + head * 64 + (((lane & 7) ^ ((i4 & 1) << 2)) << 3);
    LAS unsigned char* reg = lds + w * 16384;
#define D16_ISSUE(st, buf) do { const size_t _o = (size_t)(st) * 256 * ZP; LAS unsigned char* _b = reg + (buf) * 8192; \
        _Pragma("unroll") for (int j = 0; j < 4; ++j) { GLDS16A(kbase + _o + (size_t)j * 64 * ZP + (((j & 1) ? (kch ^ 4) : kch) << 3), _b + j * 1024); \
                                                        GLDS16A(vbase + _o + (size_t)j * 64 * ZP, _b + 4096 + j * 1024); } } while (0)
    const int swz = (r32 >> 1) & 7;
    int kaddr[4];
#pragma unroll
    for (int d0 = 0; d0 < 4; ++d0) kaddr[d0] = r32 * 128 + (((2 * d0 + hi) ^ swz) << 4);
    const int q4 = (lane >> 2) & 3, gb = (lane >> 4) & 1, p4 = lane & 3;
    int vaddr[2];
#pragma unroll
    for (int d = 0; d < 2; ++d) vaddr[d] = (4 * hi + q4) * 128 + ((d ^ (q4 >> 1)) << 6) + 32 * gb + 8 * p4;
    __syncthreads();
    asm volatile("s_waitcnt vmcnt(0)" ::: "memory");
    D16_ISSUE(0, 0);
    for (int st = 0; st < NST; ++st) {
        if (st + 1 < NST) { D16_ISSUE(st + 1, (st + 1) & 1); asm volatile("s_waitcnt vmcnt(8)" ::: "memory"); }
        else asm volatile("s_waitcnt vmcnt(0)" ::: "memory");
        const LAS unsigned char* B = reg + (st & 1) * 8192;
        const int dT = kstart + st * 256 - blk;
        f32x16 p0;
#pragma unroll
        for (int d0 = 0; d0 < 4; ++d0) { const bf16x8 ka = *(const LAS bf16x8*)(B + kaddr[d0]);
            if (d0 == 0) p0 = MFMA32(ka, qf[d0], am); else p0 = MFMA32(ka, qf[d0], p0); }
        if (dT < -768 || dT > 768) {
#pragma unroll
            for (int r = 0; r < 16; ++r) { const int kk = (r & 3) + 8 * (r >> 2) + 4 * hi; const int d = dT + 16 * ((kk >> 1) - (r32 >> 1));
                p0[r] = (d <= 1024 && d >= -1024) ? p0[r] : -INFINITY; }
        }
        float rm = max3f(p0[0], p0[1], p0[2]);
#pragma unroll
        for (int r = 3; r < 15; r += 2) rm = max3f(rm, p0[r], p0[r + 1]);
        rm = halfmax(max2f(rm, p0[15]));
        const bool resc = __any(rm > m_run + 8.f);
        if (resc) { const float mn = max2f(m_run, rm); const float f = fast_exp2(m_run - mn); m_run = mn; l_run *= f; if (hi == 0) wsf[r32] = f; }
        const float mm = m_run; float sm = 0.f;
#pragma unroll
        for (int r = 0; r < 16; ++r) { p0[r] = fast_exp2(p0[r] - mm); sm += p0[r]; }
        l_run += sm;
        const bf16x8 pa0 = pack8(p0, 0), pa1 = pack8(p0, 8);
        if (resc) {
#pragma unroll
            for (int r = 0; r < 16; ++r) { const float f = wsf[crow(r, hi)]; o[0][r] *= f; o[1][r] *= f; }
        }
#pragma unroll
        for (int d = 0; d < 2; ++d) {
            const LAS unsigned char* vb = B + 4096 + vaddr[d];
            s16x4 lo, h4; bf16x8 vf;
            lo = vtr(vb); h4 = vtr(vb + 1024); vf = (bf16x8){lo[0], lo[1], lo[2], lo[3], h4[0], h4[1], h4[2], h4[3]}; o[d] = MFMA32(pa0, vf, o[d]);
            lo = vtr(vb + 2048); h4 = vtr(vb + 2048 + 1024); vf = (bf16x8){lo[0], lo[1], lo[2], lo[3], h4[0], h4[1], h4[2], h4[3]}; o[d] = MFMA32(pa1, vf, o[d]);
        }
    }
#undef D16_ISSUE
}
__device__ __forceinline__ void dil_unit(int b, int hg, int qb, bf16_t* Z, LAS unsigned char* lds) {
    const int tid = threadIdx.x, lane = tid & 63, r32 = lane & 31, hi = lane >> 5;
    const int w = __builtin_amdgcn_readfirstlane(tid >> 6);
    const size_t rowbase = (size_t)b * SEQ;
    LAS float* wsf = (LAS float*)(lds + 131072) + w * 64;
    float m_run = -1e30f, l_run = 0.f;
    f32x16 o[2];
#pragma unroll
    for (int d = 0; d < 2; ++d)
#pragma unroll
        for (int r = 0; r < 16; ++r) o[d][r] = 0.f;
    dil_group<1>(0, rowbase, hg, qb, Z, lds, m_run, l_run, o, lane, r32, hi, w, wsf);
    dil_group4(rowbase, hg, qb, Z, lds, m_run, l_run, o, lane, r32, hi, w, wsf);
    dil_group16(rowbase, hg, qb, Z, lds, m_run, l_run, o, lane, r32, hi, w, wsf);
    const float lt = halfsum(l_run);
    if (hi == 0) wsf[r32] = fast_rcp(lt);
    bf16_t* op = Z + (rowbase + qb * 256 + 2 * w) * ZP + ZC_QD + hg * 64 + r32;
#pragma unroll
    for (int r = 0; r < 16; ++r) { const int q = crow(r, hi); const float il = wsf[q]; const int trow = 16 * (q >> 1) + (q & 1);
#pragma unroll
        for (int d = 0; d < 2; ++d) { const unsigned pk = cvtpk(o[d][r] * il, 0.f); op[(size_t)trow * ZP + d * 32] = (bf16_t)(pk & 0xffffu); } }
    __syncthreads();
}

__device__ __forceinline__ void ld_f32_row(const float* row, int lane, f32x4 (&v)[4]) {
    const f32x4* p = (const f32x4*)row + lane;
#pragma unroll
    for (int j = 0; j < 4; ++j) v[j] = p[64 * j];
}
__device__ __forceinline__ void ld_bf16_row(const bf16_t* row, int lane, f32x4 (&v)[4]) {
    const u32x2* p = (const u32x2*)row + lane;
#pragma unroll
    for (int j = 0; j < 4; ++j) { const u32x2 w = p[64 * j]; v[j] = (f32x4){bflo(w.x), bfhi(w.x), bflo(w.y), bfhi(w.y)}; }
}
__device__ __forceinline__ void st_f32_row(float* row, int lane, const f32x4 (&v)[4]) {
    f32x4* p = (f32x4*)row + lane;
#pragma unroll
    for (int j = 0; j < 4; ++j) p[64 * j] = v[j];
}
__device__ __forceinline__ void st_bf16_row(bf16_t* row, int lane, const f32x4 (&v)[4]) {
    u32x2* p = (u32x2*)row + lane;
#pragma unroll
    for (int j = 0; j < 4; ++j) { u32x2 w; w.x = cvtpk(v[j][0], v[j][1]); w.y = cvtpk(v[j][2], v[j][3]); p[64 * j] = w; }
}
__device__ __forceinline__ float row_rstd(const f32x4 (&v)[4]) {
    float s = 0.f;
#pragma unroll
    for (int j = 0; j < 4; ++j) s += (v[j][0] * v[j][0] + v[j][1] * v[j][1]) + (v[j][2] * v[j][2] + v[j][3] * v[j][3]);
    return 1.0f / sqrtf(wave_sum(s) * (1.f / DM) + EPS);
}
__device__ __forceinline__ void add_normed(f32x4 (&acc)[4], const f32x4 (&y)[4], const float* g, int lane, float scale) {
    const float r = row_rstd(y) * scale; f32x4 gv[4]; ld_f32_row(g, lane, gv);
#pragma unroll
    for (int j = 0; j < 4; ++j) acc[j] = acc[j] + y[j] * r * gv[j];
}
__device__ __forceinline__ void norm_to_bf16(const f32x4 (&x)[4], const float* g, int lane, bf16_t* orow) {
    const float r = row_rstd(x); f32x4 gv[4]; ld_f32_row(g, lane, gv); f32x4 t[4];
#pragma unroll
    for (int j = 0; j < 4; ++j) t[j] = x[j] * r * gv[j];
    st_bf16_row(orow, lane, t);
}

__device__ __forceinline__ int gu_map(int n0) { return n0 < DFF ? (((n0 >> 7) << 8) + (n0 & 127)) : ((((n0 - DFF) >> 7) << 8) + 128 + ((n0 - DFF) & 127)); }
template <bool GU>
__device__ __forceinline__ void transpose_item(const float* W, int K, int N, bf16_t* WT, LAS float* scr, int item, int lane) {
    const int nblk = N / 32, kb = item / nblk, nb = item % nblk, k0 = 64 * kb, n0 = 32 * nb;
    const int r0 = GU ? gu_map(n0) : n0;
#pragma unroll 8
    for (int i = 0; i < 32; ++i) { const int kk = 2 * i + (lane >> 5); scr[kk * 33 + (lane & 31)] = W[(size_t)(k0 + kk) * N + n0 + (lane & 31)]; }
    asm volatile("s_waitcnt lgkmcnt(0)" ::: "memory");
    const int c = lane & 7;
#pragma unroll
    for (int j = 0; j < 4; ++j) { const int n = (lane >> 3) + 8 * j; const LAS float* s = scr + (8 * c) * 33 + n;
        u32x4 o; o.x = cvtpk(s[0 * 33], s[1 * 33]); o.y = cvtpk(s[2 * 33], s[3 * 33]); o.z = cvtpk(s[4 * 33], s[5 * 33]); o.w = cvtpk(s[6 * 33], s[7 * 33]);
        *(u32x4*)(WT + (size_t)(r0 + n) * K + k0 + 8 * c) = o; }
    asm volatile("s_waitcnt lgkmcnt(0)" ::: "memory");
}
__device__ __forceinline__ void sincos_d(double a, float& c, float& s) {
    const double TWO_PI = 6.283185307179586476925, INV_2PI = 0.15915494309189533577;
    const double k = __builtin_rint(a * INV_2PI); const double r = a - k * TWO_PI, r2 = r * r;
    double sp = -1.0 / 121645100408832000.0;
    sp = sp * r2 + 1.0 / 355687428096000.0; sp = sp * r2 - 1.0 / 1307674368000.0; sp = sp * r2 + 1.0 / 6227020800.0; sp = sp * r2 - 1.0 / 39916800.0;
    sp = sp * r2 + 1.0 / 362880.0; sp = sp * r2 - 1.0 / 5040.0; sp = sp * r2 + 1.0 / 120.0; sp = sp * r2 - 1.0 / 6.0; sp = sp * r2 + 1.0;
    double cp = 1.0 / 2432902008176640000.0;
    cp = cp * r2 - 1.0 / 6402373705728000.0; cp = cp * r2 + 1.0 / 20922789888000.0; cp = cp * r2 - 1.0 / 87178291200.0; cp = cp * r2 + 1.0 / 479001600.0;
    cp = cp * r2 - 1.0 / 3628800.0; cp = cp * r2 + 1.0 / 40320.0; cp = cp * r2 - 1.0 / 720.0; cp = cp * r2 + 1.0 / 24.0; cp = cp * r2 - 0.5; cp = cp * r2 + 1.0;
    s = (float)(sp * r); c = (float)cp;
}

constexpr int N_PHASES = 12;

__device__ __forceinline__ bool ph_in(int k) {
    kargs_t p = (kargs_t)__builtin_amdgcn_kernarg_segment_ptr(); asm volatile("" : "+s"(p)); return p->ph_lo <= k && k < p->ph_hi;
}
__device__ __forceinline__ void grid_bar(unsigned* bar, unsigned G) {
    asm volatile("s_waitcnt vmcnt(0)" ::: "memory");
    __syncthreads();
    if (threadIdx.x == 0) {
        __builtin_amdgcn_fence(__ATOMIC_RELEASE, "agent");
        const unsigned gen = __hip_atomic_load(bar + 64, __ATOMIC_RELAXED, __HIP_MEMORY_SCOPE_AGENT);
        const unsigned old = __hip_atomic_fetch_add(bar, 1u, __ATOMIC_RELAXED, __HIP_MEMORY_SCOPE_AGENT);
        if (old == G - 1u) {
            __hip_atomic_store(bar, 0u, __ATOMIC_RELAXED, __HIP_MEMORY_SCOPE_AGENT);
            __hip_atomic_fetch_add(bar + 64, 1u, __ATOMIC_RELEASE, __HIP_MEMORY_SCOPE_AGENT);
        } else {
            unsigned spins = 0;
            while (__hip_atomic_load(bar + 64, __ATOMIC_RELAXED, __HIP_MEMORY_SCOPE_AGENT) == gen) { __builtin_amdgcn_s_sleep(2); if (++spins > (1u << 26)) break; }
        }
        __builtin_amdgcn_fence(__ATOMIC_ACQUIRE, "agent");
        asm volatile("s_waitcnt vmcnt(0)" ::: "memory");
    }
    __syncthreads();
}
__global__ void __launch_bounds__(NTHREADS) fwd_megakernel(Args a) {
    extern __shared__ __attribute__((aligned(16))) unsigned char lds_raw[];
    LAS unsigned char* lds = (LAS unsigned char*)lds_raw;
    cg::grid_group grid = cg::this_grid();
#define PHASE_PTRS() int tid = threadIdx.x; asm volatile("" : "+v"(tid)); const int lane = tid & 63, wave = __builtin_amdgcn_readfirstlane(tid >> 6); \
    int bx = blockIdx.x; asm volatile("" : "+s"(bx)); const int G = gridDim.x; \
    const int vcu = (G % 8 == 0) ? (bx % 8) * (G / 8) + bx / 8 : bx; const int gw = vcu * 8 + wave, NGW = G * 8; (void)lane; (void)gw; (void)NGW; (void)vcu; \
    kargs_t ka = (kargs_t)__builtin_amdgcn_kernarg_segment_ptr(); asm volatile("" : "+s"(ka)); \
    unsigned char* ws = ka->ws; float* out = ka->out; const float* x = ka->in[IN_X]; (void)x; (void)out; \
    bf16_t* XN = (bf16_t*)(ws + WS_XN); bf16_t* Y1 = (bf16_t*)(ws + WS_Y1); bf16_t* Zb = (bf16_t*)(ws + WS_Z); bf16_t* Gb = (bf16_t*)out; \
    (void)XN; (void)Y1; (void)Zb; (void)Gb
#ifndef PHASE_MASK
#define PHASE_MASK 0xFFF
#endif
#define IN(k) (((PHASE_MASK >> (k)) & 1) && ph_in(k))
#define SEAM(k) do { if (IN(k) && IN((k) + 1)) { if ((k) == 0) grid.sync(); else grid_bar((unsigned*)a.ws, gridDim.x); } } while (0)

    if (IN(0)) {
        PHASE_PTRS();
        bf16_t* Win_t = (bf16_t*)(ws + WS_WIN); bf16_t* Wpa_t = (bf16_t*)(ws + WS_WPA); bf16_t* Wpb_t = (bf16_t*)(ws + WS_WPB); bf16_t* Wout_t = (bf16_t*)(ws + WS_WOUT);
        bf16_t* Wgu2_t = (bf16_t*)(ws + WS_WGU2); bf16_t* Wd2_t = (bf16_t*)(ws + WS_WD2);
        bf16_t* Wgu1_t = (bf16_t*)((unsigned char*)out + OUT_WGU1); bf16_t* Wd1_t = (bf16_t*)((unsigned char*)out + OUT_WD1);
        float* rope = (float*)(ws + WS_ROPE);
        LAS float* scr = (LAS float*)(lds + wave * 16384);
        constexpr int I_IN = 16 * (NIN / 32), I_SQ = 16 * 32, I_PB = 4 * 32, I_GU = 16 * (NGU / 32), I_DN = (DFF / 64) * 32;
        constexpr int NITEMS = I_IN + 2 * I_SQ + I_PB + 2 * I_GU + 2 * I_DN;
        for (int it = gw; it < NITEMS; it += NGW) {
            int r = it;
            if (r < I_GU) { transpose_item<true>(ka->in[IN_WGU1], DM, NGU, Wgu1_t, scr, r, lane); continue; } r -= I_GU;
            if (r < I_DN) { transpose_item<false>(ka->in[IN_WD1], DFF, DM, Wd1_t, scr, r, lane); continue; } r -= I_DN;
            if (r < I_IN) { transpose_item<false>(ka->in[IN_WIN], DM, NIN, Win_t, scr, r, lane); continue; } r -= I_IN;
            if (r < I_SQ) { transpose_item<false>(ka->in[IN_WPA], DM, DM, Wpa_t, scr, r, lane); continue; } r -= I_SQ;
            if (r < I_PB) { transpose_item<false>(ka->in[IN_WPB], 256, DM, Wpb_t, scr, r, lane); continue; } r -= I_PB;
            if (r < I_SQ) { transpose_item<false>(ka->in[IN_WOUT], DM, DM, Wout_t, scr, r, lane); continue; } r -= I_SQ;
            if (r < I_GU) { transpose_item<true>(ka->in[IN_WGU2], DM, NGU, Wgu2_t, scr, r, lane); continue; } r -= I_GU;
            transpose_item<false>(ka->in[IN_WD2], DFF, DM, Wd2_t, scr, r, lane);
        }
        {
            const int* pos = (const int*)ka->in[IN_POS];
            const float invf[8] = {1.0f, 0.1939227432012558f, 0.03760603070259094f, 0.007292664609849453f, 0.0014142135623842478f, 0.00027424818836152554f, 5.3182957344688475e-05f, 1.0313385246263351e-05f};
            for (int i = bx * NTHREADS + tid; i < MROWS * 8; i += G * NTHREADS) {
                const int row = i >> 3, f = i & 7;
                float fv = invf[0];
#pragma unroll
                for (int q = 1; q < 8; ++q) fv = (f == q) ? invf[q] : fv;
                const float ang = (float)pos[row] * fv; float c, s; sincos_d((double)ang, c, s);
                rope[(size_t)row * 16 + f] = c; rope[(size_t)row * 16 + 8 + f] = s;
            }
        }
        for (int m = gw; m < MROWS; m += NGW) { f32x4 v[4]; ld_f32_row(x + (size_t)m * DM, lane, v); norm_to_bf16(v, ka->in[IN_GPRE1], lane, XN + (size_t)m * DM); }
        if (bx == 0 && tid == 0) { __hip_atomic_store((unsigned*)ws, 0u, __ATOMIC_RELAXED, __HIP_MEMORY_SCOPE_AGENT); __hip_atomic_store((unsigned*)ws + 64, 0u, __ATOMIC_RELAXED, __HIP_MEMORY_SCOPE_AGENT); }
        __syncthreads();
    }
    SEAM(0);
    if (IN(1)) {
        PHASE_PTRS(); bf16_t* Hb = Zb; bf16_t* Wgu1_t = (bf16_t*)((unsigned char*)out + OUT_WGU1);
        pg8::Gemm g{XN, Wgu1_t, MROWS, NGU, DM, DM}; pg8::StaticOrder S; S.init(MROWS, NGU, G, bx);
        pg8::EpiT<pg8::EPI_SWIGLU> E{Hb, DFF, nullptr, nullptr};
        pg8::gemm_phase<pg8::EpiT<pg8::EPI_SWIGLU>, true>(lds, g, S, E);
    }
    SEAM(1);
    if (IN(2)) {
        PHASE_PTRS(); bf16_t* Hb = Zb; bf16_t* Wd1_t = (bf16_t*)((unsigned char*)out + OUT_WD1);
        pg8::Gemm g{Hb, Wd1_t, MROWS, DM, DFF, DFF}; pg8::StaticOrder S; S.init(MROWS, DM, G, bx);
        pg8::EpiT<pg8::EPI_PLAIN> E{Y1, DM, nullptr, nullptr};
        pg8::gemm_phase<pg8::EpiT<pg8::EPI_PLAIN>, true>(lds, g, S, E);
    }
    SEAM(2);
    if (IN(3)) {
        PHASE_PTRS();
        for (int m = gw; m < MROWS; m += NGW) {
            f32x4 xv[4], y[4]; ld_f32_row(x + (size_t)m * DM, lane, xv); ld_bf16_row(Y1 + (size_t)m * DM, lane, y);
            add_normed(xv, y, ka->in[IN_GPOST1], lane, 0.5f);
            norm_to_bf16(xv, ka->in[IN_GPREM], lane, XN + (size_t)m * DM);
        }
    }
    SEAM(3);
    if (IN(4)) {
        PHASE_PTRS(); bf16_t* Win_t = (bf16_t*)(ws + WS_WIN); float* rope = (float*)(ws + WS_ROPE);
        pg8::Gemm g{XN, Win_t, MROWS, NIN, DM, DM}; pg8::StaticOrder S; S.init(MROWS, NIN, G, bx);
        pg8::EpiT<pg8::EPI_WIN> E{Zb, ZP, Gb, rope};
        pg8::gemm_phase<pg8::EpiT<pg8::EPI_WIN>, true>(lds, g, S, E);
    }
    SEAM(4);
    if (IN(5)) {
        PHASE_PTRS();
        float lam;
        { const float d1 = wave_sum(ka->in[IN_LQ1][lane] * ka->in[IN_LK1][lane]), d2 = wave_sum(ka->in[IN_LQ2][lane] * ka->in[IN_LK2][lane]);
          lam = fast_exp2(d1 * LOG2E) - fast_exp2(d2 * LOG2E) + LAMBDA_INIT; }
#ifndef NO_DIL
        for (int u = vcu; u < BATCH * 4 * 32; u += G) { const int bh = u >> 5, qb = u & 31; dil_unit(bh >> 2, bh & 3, qb, Zb, lds); }
#endif
        __syncthreads();
#ifndef NO_DIFF
        for (int u = vcu; u < BATCH * 8 * 32; u += G) { const int bh = u >> 5, qb = u & 31; diff_unit<8>(bh >> 3, bh & 7, qb, Zb, ka->in[IN_GSUB], lam, lds); }
#endif
        __syncthreads();
    }
    SEAM(5);
    if (IN(6)) {
        PHASE_PTRS(); bf16_t* MERGED = XN; bf16_t* Wpa_t = (bf16_t*)(ws + WS_WPA); bf16_t* Wpb_t = (bf16_t*)(ws + WS_WPB);
#ifndef NO_PB
        { int kpb = 256; asm volatile("" : "+s"(kpb));
          pg8::Gemm g{Zb + ZC_QD, Wpb_t, MROWS, DM, kpb, ZP}; pg8::StaticOrder S; S.init(MROWS, DM, G, bx);
          pg8::EpiT<pg8::EPI_PROJB> E{MERGED, DM, Gb, nullptr};
          pg8::gemm_phase<pg8::EpiT<pg8::EPI_PROJB>, true>(lds, g, S, E); }
#endif
#ifndef NO_PA
        { pg8::Gemm g{Zb, Wpa_t, MROWS, DM, DM, ZP}; pg8::StaticOrder S; S.init(MROWS, DM, G, bx);
          pg8::EpiT<pg8::EPI_PROJA> E{MERGED, DM, Gb, nullptr};
          pg8::gemm_phase<pg8::EpiT<pg8::EPI_PROJA>, true>(lds, g, S, E); }
#endif
    }
    SEAM(6);
    if (IN(7)) {
        PHASE_PTRS(); bf16_t* MERGED = XN; bf16_t* Y2 = Zb; bf16_t* Wout_t = (bf16_t*)(ws + WS_WOUT);
        pg8::Gemm g{MERGED, Wout_t, MROWS, DM, DM, DM}; pg8::StaticOrder S; S.init(MROWS, DM, G, bx);
        pg8::EpiT<pg8::EPI_PLAIN> E{Y2, DM, nullptr, nullptr};
        pg8::gemm_phase<pg8::EpiT<pg8::EPI_PLAIN>, true>(lds, g, S, E);
    }
    SEAM(7);
    if (IN(8)) {
        PHASE_PTRS(); bf16_t* Y2 = Zb;
        for (int m = gw; m < MROWS; m += NGW) {
            f32x4 xv[4], y[4]; ld_f32_row(x + (size_t)m * DM, lane, xv); ld_bf16_row(Y1 + (size_t)m * DM, lane, y);
            add_normed(xv, y, ka->in[IN_GPOST1], lane, 0.5f);
            ld_bf16_row(Y2 + (size_t)m * DM, lane, y);
            add_normed(xv, y, ka->in[IN_GPOSTM], lane, 1.0f);
            st_f32_row(out + (size_t)m * DM, lane, xv);
            norm_to_bf16(xv, ka->in[IN_GPRE2], lane, XN + (size_t)m * DM);
        }
    }
    SEAM(8);
    if (IN(9)) {
        PHASE_PTRS(); bf16_t* Hb = Zb; bf16_t* Wgu2_t = (bf16_t*)(ws + WS_WGU2);
        pg8::Gemm g{XN, Wgu2_t, MROWS, NGU, DM, DM}; pg8::StaticOrder S; S.init(MROWS, NGU, G, bx);
        pg8::EpiT<pg8::EPI_SWIGLU> E{Hb, DFF, nullptr, nullptr};
        pg8::gemm_phase<pg8::EpiT<pg8::EPI_SWIGLU>, true>(lds, g, S, E);
    }
    SEAM(9);
    if (IN(10)) {
        PHASE_PTRS(); bf16_t* Hb = Zb; bf16_t* Y3 = Y1; bf16_t* Wd2_t = (bf16_t*)(ws + WS_WD2);
        pg8::Gemm g{Hb, Wd2_t, MROWS, DM, DFF, DFF}; pg8::StaticOrder S; S.init(MROWS, DM, G, bx);
        pg8::EpiT<pg8::EPI_PLAIN> E{Y3, DM, nullptr, nullptr};
        pg8::gemm_phase<pg8::EpiT<pg8::EPI_PLAIN>, true>(lds, g, S, E);
    }
    SEAM(10);
    if (IN(11)) {
        PHASE_PTRS(); bf16_t* Y3 = Y1;
        for (int m = gw; m < MROWS; m += NGW) {
            f32x4 xv[4], y[4]; ld_f32_row(out + (size_t)m * DM, lane, xv); ld_bf16_row(Y3 + (size_t)m * DM, lane, y);
            add_normed(xv, y, ka->in[IN_GPOST2], lane, 0.5f);
            st_f32_row(out + (size_t)m * DM, lane, xv);
        }
    }
#undef IN
#undef SEAM
}

extern "C" void kernel_launch(void* const* d_in, const int* in_sizes, int n_in, void* d_out, int out_size, void* d_ws, size_t ws_size, hipStream_t stream) {
    static int grid = 0;
    if (grid == 0) {
        if (n_in != 21 || out_size != MROWS * DM || ws_size < WS_END) { fprintf(stderr, "kernel_launch: unexpected shapes (n_in %d out %d ws %zu)\n", n_in, out_size, ws_size); grid = -1; return; }
        int dev = 0, cus = 0, per_cu = 0;
        (void)hipGetDevice(&dev); (void)hipDeviceGetAttribute(&cus, hipDeviceAttributeMultiprocessorCount, dev);
        if (hipFuncSetAttribute((const void*)fwd_megakernel, hipFuncAttributeMaxDynamicSharedMemorySize, LDS_BYTES) != hipSuccess) { fprintf(stderr, "kernel_launch: hipFuncSetAttribute failed\n"); grid = -1; return; }
        if (hipOccupancyMaxActiveBlocksPerMultiprocessor(&per_cu, (const void*)fwd_megakernel, NTHREADS, LDS_BYTES) != hipSuccess || per_cu < 1) { fprintf(stderr, "kernel_launch: occupancy query says %d\n", per_cu); per_cu = 1; (void)hipGetLastError(); }
        grid = cus * per_cu;
    }
    if (grid < 0) return;
    Args a{};
    for (int i = 0; i < 21; ++i) a.in[i] = (const float*)d_in[i];
    a.out = (float*)d_out; a.ws = (unsigned char*)d_ws;
#if MK_N_LAUNCHES == 1
    a.ph_lo = 0; a.ph_hi = N_PHASES;
    void* args[] = {&a};
    hipError_t e = hipLaunchCooperativeKernel((const void*)fwd_megakernel, dim3(grid), dim3(NTHREADS), args, LDS_BYTES, stream);
    if (e != hipSuccess) fprintf(stderr, "cooperative launch failed: %s (grid %d)\n", hipGetErrorString(e), grid);
#else
    for (int p = 0; p < N_PHASES; ++p) { a.ph_lo = p; a.ph_hi = p + 1; hipLaunchKernelGGL(fwd_megakernel, dim3(grid), dim3(NTHREADS), LDS_BYTES, stream, a); }
#endif
}
```

```cpp
#include <hip/hip_runtime.h>
#include <hip/hip_cooperative_groups.h>
#include <cstdio>
#include <cstdint>
namespace cg = cooperative_groups;

#ifndef MK_N_LAUNCHES
#define MK_N_LAUNCHES 1
#endif

#define LAS __attribute__((address_space(3)))
typedef unsigned short bf16_t;
typedef short bf16x8 __attribute__((ext_vector_type(8)));
typedef short s16x4 __attribute__((ext_vector_type(4)));
typedef float f32x4 __attribute__((ext_vector_type(4)));
typedef float f32x16 __attribute__((ext_vector_type(16)));
typedef unsigned u32x4 __attribute__((ext_vector_type(4)));
typedef unsigned u32x2 __attribute__((ext_vector_type(2)));
typedef float f32x2_t __attribute__((ext_vector_type(2)));
typedef __bf16 bf16x2_t __attribute__((ext_vector_type(2)));

constexpr int BATCH = 4, SEQ = 8192, DM = 1024, MROWS = BATCH * SEQ, DFF = 2816, NGU = 2 * DFF, NIN = 7424;
constexpr int ZP = 5376;
constexpr int GP = 2048;
constexpr int ZC_KA = 1024, ZC_VA = 2048, ZC_QD = 3072, ZC_KD = 3840, ZC_VD = 4608;
constexpr float EPS = 1e-6f;
constexpr float LOG2E = 1.4426950408889634f;
constexpr float C2 = 0.125f * LOG2E;
constexpr float LAMBDA_INIT = 0.2f;

constexpr size_t MiB = 1u << 20;
constexpr size_t WS_ROPE = 1 * MiB;
constexpr size_t WS_WIN = 4 * MiB;
constexpr size_t WS_WPA = 19 * MiB;
constexpr size_t WS_WPB = 21 * MiB;
constexpr size_t WS_WOUT = 22 * MiB;
constexpr size_t WS_WGU2 = 24 * MiB;
constexpr size_t WS_WD2 = 35 * MiB;
constexpr size_t WS_XN = 41 * MiB;
constexpr size_t WS_Y1 = 105 * MiB;
constexpr size_t WS_Z = 169 * MiB;
constexpr size_t WS_END = 505 * MiB;
constexpr size_t OUT_WGU1 = 0, OUT_WD1 = 11 * MiB;

constexpr int LDS_BYTES = 139264;
constexpr int NTHREADS = 512;

__device__ __forceinline__ unsigned cvtpk(float lo, float hi) { f32x2_t v = {lo, hi}; bf16x2_t b = __builtin_convertvector(v, bf16x2_t); return __builtin_bit_cast(unsigned, b); }
__device__ __forceinline__ float bflo(unsigned w) { return __uint_as_float(w << 16); }
__device__ __forceinline__ float bfhi(unsigned w) { return __uint_as_float(w & 0xffff0000u); }
__device__ __forceinline__ float fast_rcp(float x) { return __builtin_amdgcn_rcpf(x); }
__device__ __forceinline__ float fast_exp2(float x) { return __builtin_amdgcn_exp2f(x); }
__device__ __forceinline__ float sigmoidf_(float x) { return fast_rcp(1.f + fast_exp2(-x * LOG2E)); }
__device__ __forceinline__ float wave_sum(float v) {
#pragma unroll
    for (int o = 1; o < 64; o <<= 1) v += __shfl_xor(v, o);
    return v;
}

namespace pg8 {
constexpr int BM = 256, BK = 64, HALF = 128, HTB = HALF * BK * 2, STAGE_BYTES = 8 * HTB, NXCD = 8, WGM = 4;
__host__ __device__ __forceinline__ int lds_byte(int r, int c) { const int st = (r >> 4) * 2 + (c >> 5), rr = r & 15, cc = c & 31, ob = rr * 64 + cc * 2; return st * 1024 + (ob ^ (((ob >> 9) & 1) << 5)); }
__host__ __device__ __forceinline__ void stage_rc(int b, int& R, int& C) { const int st = b / 1024, sb = b % 1024, swz = sb ^ (((sb >> 9) & 1) << 5); R = (st >> 1) * 16 + swz / 64; C = (st & 1) * 32 + (swz % 64) / 2; }
__host__ __device__ __forceinline__ int perm32(int rho) { const int n = rho >> 4, i = rho & 15; return 8 * (i >> 2) + 4 * n + (i & 3); }

struct Unit { int pm, pn; };
struct Gemm { const bf16_t* A; const bf16_t* Bt; int M, N, K, lda; };

struct StaticOrder {
    int nM, nN, nwg, G, c;
    __device__ void init(int M, int N, int G_, int c_) { nM = M / BM; nN = N / BM; nwg = nM * nN; G = G_; c = c_; }
    __device__ bool next(int i, Unit& u) const {
        const long L = (long)i * G + c; if (L >= nwg) return false;
        int wgid = (int)L; { const int q = nwg / NXCD, r = nwg % NXCD, xcd = wgid % NXCD, off = wgid / NXCD; wgid = (xcd < r ? xcd * (q + 1) : r * (q + 1) + (xcd - r) * q) + off; }
        const int nig = WGM * nN, gid = wgid / nig, fm = gid * WGM, gsz = (nM - fm) < WGM ? (nM - fm) : WGM;
        u.pm = fm + ((wgid % nig) % gsz); u.pn = (wgid % nig) / gsz; return true;
    }
};

enum { EPI_PLAIN = 0, EPI_SWIGLU = 1, EPI_WIN = 2, EPI_PROJB = 3, EPI_PROJA = 4 };
template <int MODE> struct EpiT {
    static constexpr bool PERM = true;
    bf16_t* O; int ldc;
    bf16_t* G;
    const float* rope;
    __device__ __forceinline__ void operator()(const f32x4 (&acc)[2][2][4][2], const Unit& u, int wr, int wc, int fr, int fq) const {
        const int row0 = u.pm * BM + wr * 64 + fr;
        if constexpr (MODE == EPI_PLAIN) {
            const int col0 = u.pn * BM + wc * 32 + 8 * fq;
#pragma unroll
            for (int ai = 0; ai < 2; ++ai)
#pragma unroll
                for (int m = 0; m < 4; ++m) { bf16_t* rowp = O + (size_t)(row0 + ai * HALF + m * 16) * ldc + col0;
#pragma unroll
                    for (int bj = 0; bj < 2; ++bj) { const f32x4 v0 = acc[ai][bj][m][0], v1 = acc[ai][bj][m][1];
                        u32x4 w; w.x = cvtpk(v0[0], v0[1]); w.y = cvtpk(v0[2], v0[3]); w.z = cvtpk(v1[0], v1[1]); w.w = cvtpk(v1[2], v1[3]);
                        *(u32x4*)(rowp + bj * HALF) = w; } }
        } else if constexpr (MODE == EPI_SWIGLU) {
            const int col0 = u.pn * HALF + wc * 32 + 8 * fq;
#pragma unroll
            for (int ai = 0; ai < 2; ++ai)
#pragma unroll
                for (int m = 0; m < 4; ++m) { bf16_t* rowp = O + (size_t)(row0 + ai * HALF + m * 16) * ldc + col0;
                    float h[8];
#pragma unroll
                    for (int n = 0; n < 2; ++n)
#pragma unroll
                        for (int e = 0; e < 4; ++e) { const float g = acc[ai][0][m][n][e], uu = acc[ai][1][m][n][e]; h[4 * n + e] = g * sigmoidf_(g) * uu; }
                    u32x4 w; w.x = cvtpk(h[0], h[1]); w.y = cvtpk(h[2], h[3]); w.z = cvtpk(h[4], h[5]); w.w = cvtpk(h[6], h[7]);
                    *(u32x4*)rowp = w; }
        } else if constexpr (MODE == EPI_WIN) {
            const int pn = u.pn;
            if (pn >= 21) {
                const int col0 = (pn - 21) * BM + wc * 32 + 8 * fq;
#pragma unroll
                for (int ai = 0; ai < 2; ++ai)
#pragma unroll
                    for (int m = 0; m < 4; ++m) { bf16_t* rowp = G + (size_t)(row0 + ai * HALF + m * 16) * GP + col0;
#pragma unroll
                        for (int bj = 0; bj < 2; ++bj) { const f32x4 v0 = acc[ai][bj][m][0], v1 = acc[ai][bj][m][1];
                            u32x4 w; w.x = cvtpk(sigmoidf_(v0[0]), sigmoidf_(v0[1])); w.y = cvtpk(sigmoidf_(v0[2]), sigmoidf_(v0[3]));
                            w.z = cvtpk(sigmoidf_(v1[0]), sigmoidf_(v1[1])); w.w = cvtpk(sigmoidf_(v1[2]), sigmoidf_(v1[3]));
                            *(u32x4*)(rowp + bj * HALF) = w; } }
            } else {
                const bool isq = (pn < 4) || (pn >= 12 && pn < 15);
                const bool isrope = (pn < 8) || (pn >= 12 && pn < 18);
                const float sc = isq ? C2 : 1.f;
                const int col0 = pn * BM + wc * 32 + 8 * fq;
                const bool dorope = isrope && ((wc & 1) == 0);
                const float sgn = (fq == 0) ? -1.f : 1.f;
#pragma unroll
                for (int ai = 0; ai < 2; ++ai)
#pragma unroll
                    for (int m = 0; m < 4; ++m) { const int row = row0 + ai * HALF + m * 16; bf16_t* rowp = O + (size_t)row * ZP + col0;
                        f32x4 cs0 = {1.f, 1.f, 1.f, 1.f}, cs1 = cs0, sn0 = {0.f, 0.f, 0.f, 0.f}, sn1 = sn0;
                        if (dorope) { const f32x4* rp = (const f32x4*)(rope + (size_t)row * 16); cs0 = rp[0]; cs1 = rp[1]; sn0 = rp[2]; sn1 = rp[3]; }
#pragma unroll
                        for (int bj = 0; bj < 2; ++bj) { f32x4 v0 = acc[ai][bj][m][0], v1 = acc[ai][bj][m][1];
                            if (dorope) {
                                f32x4 o0, o1;
#pragma unroll
                                for (int e = 0; e < 4; ++e) { o0[e] = __shfl_xor(v0[e], 16); o1[e] = __shfl_xor(v1[e], 16); }
                                if (fq < 2) { v0 = v0 * cs0 + sgn * o0 * sn0; v1 = v1 * cs1 + sgn * o1 * sn1; }
                            }
                            v0 = v0 * sc; v1 = v1 * sc;
                            u32x4 w; w.x = cvtpk(v0[0], v0[1]); w.y = cvtpk(v0[2], v0[3]); w.z = cvtpk(v1[0], v1[1]); w.w = cvtpk(v1[2], v1[3]);
                            *(u32x4*)(rowp + bj * HALF) = w; } }
            }
        } else {
            const int col0 = u.pn * BM + wc * 32 + 8 * fq;
            const int gcol0 = (MODE == EPI_PROJB ? 1024 : 0) + col0;
#pragma unroll
            for (int ai = 0; ai < 2; ++ai)
#pragma unroll
                for (int m = 0; m < 4; ++m) { const int row = row0 + ai * HALF + m * 16; bf16_t* rowp = O + (size_t)row * ldc + col0; const bf16_t* gp = G + (size_t)row * GP + gcol0;
#pragma unroll
                    for (int bj = 0; bj < 2; ++bj) { const f32x4 v0 = acc[ai][bj][m][0], v1 = acc[ai][bj][m][1];
                        const u32x4 gw = *(const u32x4*)(gp + bj * HALF);
                        float r[8];
                        r[0] = bflo(gw.x) * v0[0]; r[1] = bfhi(gw.x) * v0[1]; r[2] = bflo(gw.y) * v0[2]; r[3] = bfhi(gw.y) * v0[3];
                        r[4] = bflo(gw.z) * v1[0]; r[5] = bfhi(gw.z) * v1[1]; r[6] = bflo(gw.w) * v1[2]; r[7] = bfhi(gw.w) * v1[3];
                        if constexpr (MODE == EPI_PROJA) { const u32x4 pw = *(const u32x4*)(rowp + bj * HALF);
                            r[0] += bflo(pw.x); r[1] += bfhi(pw.x); r[2] += bflo(pw.y); r[3] += bfhi(pw.y); r[4] += bflo(pw.z); r[5] += bfhi(pw.z); r[6] += bflo(pw.w); r[7] += bfhi(pw.w); }
                        u32x4 w; w.x = cvtpk(r[0], r[1]); w.y = cvtpk(r[2], r[3]); w.z = cvtpk(r[4], r[5]); w.w = cvtpk(r[6], r[7]);
                        *(u32x4*)(rowp + bj * HALF) = w; }
                    asm volatile("" ::: "memory"); }
        }
    }
};

template <class Epi, bool ALIGN_EPI>
__device__ __forceinline__ void gemm_phase(LAS unsigned char* lds, const Gemm g, const StaticOrder& S, const Epi& E) {
    const int tid = threadIdx.x, wid = __builtin_amdgcn_readfirstlane(tid >> 6), lane = tid & 63, wr = wid >> 2, wc = wid & 3, fr = lane & 15, fq = lane >> 4;
    const int K = g.K, nt = K / BK, lda = g.lda;
    unsigned voffA[2], voffB[2];
#pragma unroll
    for (int i = 0; i < 2; ++i) { int R, C; stage_rc(tid * 16 + i * 8192, R, C); const int Rb = Epi::PERM ? ((R & ~31) + perm32(R & 31)) : R;
        voffA[i] = (unsigned)(R * lda + C) * 2u; voffB[i] = (unsigned)(Rb * K + C) * 2u; }
    const size_t kstep = (size_t)(BK * 2);
    const size_t hstepA = (size_t)HALF * lda * 2, hstepB = (size_t)HALF * K * 2;
    const size_t tstepA = 2 * hstepA, tstepB = 2 * hstepB;
    const unsigned ldsw = (unsigned)wid * 1024u;
    const int aoff = lds_byte(wr * 64 + fr, fq * 8), boff = lds_byte(wc * 32 + fr, fq * 8);
#define PG8_SA(b, h) (((b) * 2 + (h)) * HTB)
#define PG8_SB(b, h) ((4 + (b) * 2 + (h)) * HTB)
#define PG8_STAGE(bufoff, gbase, voff) do { _Pragma("unroll") for (int _i = 0; _i < 2; ++_i) \
        __builtin_amdgcn_global_load_lds((const unsigned*)((const char*)(gbase) + (voff)[_i]), (LAS unsigned*)(lds + (bufoff) + ldsw + _i * 8192), 16, 0, 0); } while (0)
#define PG8_LDA(dst, b, h) do { _Pragma("unroll") for (int m = 0; m < 4; ++m) _Pragma("unroll") for (int k = 0; k < 2; ++k) dst[m][k] = *(const LAS bf16x8*)(lds + PG8_SA(b, h) + aoff + m * 2048 + k * 1024); } while (0)
#define PG8_LDB(dst, b, h) do { _Pragma("unroll") for (int n = 0; n < 2; ++n) _Pragma("unroll") for (int k = 0; k < 2; ++k) dst[n][k] = *(const LAS bf16x8*)(lds + PG8_SB(b, h) + boff + n * 2048 + k * 1024); } while (0)
#define PG8_MMA(ai, bj, At, Bt) do { __builtin_amdgcn_s_setprio(1); _Pragma("unroll") for (int m = 0; m < 4; ++m) _Pragma("unroll") for (int n = 0; n < 2; ++n) _Pragma("unroll") for (int k = 0; k < 2; ++k) \
        acc[ai][bj][m][n] = __builtin_amdgcn_mfma_f32_16x16x32_bf16(Bt[n][k], At[m][k], acc[ai][bj][m][n], 0, 0, 0); __builtin_amdgcn_s_setprio(0); } while (0)
#define PG8_WAIT_V(n) asm volatile("s_waitcnt vmcnt(" #n ")" ::: "memory")
#define PG8_WAIT_L(n) asm volatile("s_waitcnt lgkmcnt(" #n ")" ::: "memory")
#define PG8_BAR __builtin_amdgcn_s_barrier()
#define PG8_SCHED __builtin_amdgcn_sched_barrier(0)
    Unit cur, nxt; int ui = 0;
    if (!S.next(0, cur)) return;
    f32x4 acc[2][2][4][2];
#pragma unroll
    for (int a = 0; a < 2; ++a)
#pragma unroll
        for (int b = 0; b < 2; ++b)
#pragma unroll
            for (int m = 0; m < 4; ++m)
#pragma unroll
                for (int n = 0; n < 2; ++n) acc[a][b][m][n] = (f32x4){0.f, 0.f, 0.f, 0.f};
    bf16x8 At[4][2], B0[2][2], B1[2][2];
    const char* cA = (const char*)g.A + (size_t)cur.pm * tstepA; const char* cB = (const char*)g.Bt + (size_t)cur.pn * tstepB;
    PG8_STAGE(PG8_SB(0, 0), cB, voffB); PG8_STAGE(PG8_SB(0, 1), cB + hstepB, voffB); PG8_STAGE(PG8_SA(0, 0), cA, voffA); PG8_STAGE(PG8_SA(0, 1), cA + hstepA, voffA);
    if (wr == 1) PG8_BAR;
    PG8_WAIT_V(2); PG8_BAR;
    PG8_STAGE(PG8_SB(1, 0), cB + kstep, voffB); PG8_STAGE(PG8_SA(1, 0), cA + kstep, voffA); PG8_STAGE(PG8_SB(1, 1), cB + hstepB + kstep, voffB);
    PG8_WAIT_V(6); PG8_BAR;
    for (;;) {
        const bool has_next = S.next(ui + 1, nxt);
        const char* nA = has_next ? (const char*)g.A + (size_t)nxt.pm * tstepA : cA; const char* nB = has_next ? (const char*)g.Bt + (size_t)nxt.pn * tstepB : cB;
        for (int t = 0; t < nt; t += 2) {
            const bool last = (t == nt - 2);
            const char* a1 = cA + (size_t)(t + 1) * kstep;
            const char* a2 = last ? nA : cA + (size_t)(t + 2) * kstep; const char* b2 = last ? nB : cB + (size_t)(t + 2) * kstep;
            const char* a3 = a2 + kstep; const char* b3 = b2 + kstep;
            PG8_LDB(B0, 0, 0); PG8_LDB(B1, 0, 1); PG8_SCHED; PG8_LDA(At, 0, 0); PG8_STAGE(PG8_SA(1, 1), a1 + hstepA, voffA);
            PG8_WAIT_V(8); PG8_WAIT_L(0); PG8_BAR; PG8_MMA(0, 0, At, B0); PG8_MMA(0, 1, At, B1); PG8_BAR; PG8_SCHED;
            PG8_LDA(At, 0, 1); PG8_STAGE(PG8_SB(0, 0), b2, voffB); PG8_STAGE(PG8_SB(0, 1), b2 + hstepB, voffB); PG8_STAGE(PG8_SA(0, 0), a2, voffA);
            PG8_WAIT_V(8); PG8_WAIT_L(0); PG8_BAR; PG8_MMA(1, 0, At, B0); PG8_MMA(1, 1, At, B1); PG8_BAR; PG8_SCHED;
            PG8_LDB(B0, 1, 0); PG8_LDB(B1, 1, 1); PG8_SCHED; PG8_LDA(At, 1, 0); PG8_STAGE(PG8_SA(0, 1), a2 + hstepA, voffA);
            PG8_WAIT_V(8); PG8_WAIT_L(0); PG8_BAR; PG8_MMA(0, 0, At, B0); PG8_MMA(0, 1, At, B1); PG8_BAR; PG8_SCHED;
            PG8_LDA(At, 1, 1); PG8_STAGE(PG8_SB(1, 0), b3, voffB); PG8_STAGE(PG8_SB(1, 1), b3 + hstepB, voffB); PG8_STAGE(PG8_SA(1, 0), a3, voffA);
            PG8_WAIT_V(8); PG8_WAIT_L(0); PG8_BAR; PG8_MMA(1, 0, At, B0); PG8_MMA(1, 1, At, B1); PG8_BAR; PG8_SCHED;
        }
        if constexpr (ALIGN_EPI) { if (wr == 0) PG8_BAR; }
        E(acc, cur, wr, wc, fr, fq);
        if (!has_next) break;
#pragma unroll
        for (int a = 0; a < 2; ++a)
#pragma unroll
            for (int b = 0; b < 2; ++b)
#pragma unroll
                for (int m = 0; m < 4; ++m)
#pragma unroll
                    for (int n = 0; n < 2; ++n) acc[a][b][m][n] = (f32x4){0.f, 0.f, 0.f, 0.f};
        cur = nxt; cA = nA; cB = nB; ++ui;
        if constexpr (ALIGN_EPI) { if (wr == 1) PG8_BAR; }
    }
    PG8_WAIT_V(0);
    if constexpr (!ALIGN_EPI) { if (wr == 0) PG8_BAR; }
    PG8_BAR;
#undef PG8_SA
#undef PG8_SB
#undef PG8_STAGE
#undef PG8_LDA
#undef PG8_LDB
#undef PG8_MMA
#undef PG8_WAIT_V
#undef PG8_WAIT_L
#undef PG8_BAR
#undef PG8_SCHED
}
}

struct Args { const float* in[21]; float* out; unsigned char* ws; int ph_lo, ph_hi; };
enum { IN_X = 0, IN_POS, IN_WIN, IN_LQ1, IN_LK1, IN_LQ2, IN_LK2, IN_GSUB, IN_WPA, IN_WPB, IN_WOUT, IN_WGU1, IN_WD1, IN_WGU2, IN_WD2, IN_GPRE1, IN_GPOST1, IN_GPREM, IN_GPOSTM, IN_GPRE2, IN_GPOST2 };
typedef const __attribute__((address_space(4))) Args* kargs_t;
__device__ __forceinline__ constexpr int crow(int r, int hi) { return (r & 3) + 8 * (r >> 2) + 4 * hi; }
__device__ __forceinline__ s16x4 vtr(const LAS unsigned char* p) {
    typedef short v4i16_t __attribute__((ext_vector_type(4)));
    return __builtin_bit_cast(s16x4, __builtin_amdgcn_ds_read_tr16_b64_v4i16((LAS v4i16_t*)p));
}
__device__ __forceinline__ float max3f(float a, float b, float c) { float r; asm("v_max3_f32 %0, %1, %2, %3" : "=v"(r) : "v"(a), "v"(b), "v"(c)); return r; }
__device__ __forceinline__ float max2f(float a, float b) { float r; asm("v_max_f32_e32 %0, %1, %2" : "=v"(r) : "v"(a), "v"(b)); return r; }
__device__ __forceinline__ float rowmax32(const f32x16& p0, const f32x16& p1) {
    float a = max3f(p0[0], p0[1], p1[0]), b = max3f(p0[2], p0[3], p1[1]); a = max3f(a, p1[2], p1[3]);
#pragma unroll
    for (int r = 4; r < 16; r += 4) { a = max3f(a, p0[r], p0[r + 1]); b = max3f(b, p0[r + 2], p0[r + 3]); a = max3f(a, p1[r], p1[r + 1]); b = max3f(b, p1[r + 2], p1[r + 3]); }
    a = max2f(a, b);
    auto rr = __builtin_amdgcn_permlane32_swap(__float_as_uint(a), __float_as_uint(a), false, false);
    return max2f(__uint_as_float(rr[0]), __uint_as_float(rr[1]));
}
__device__ __forceinline__ float halfmax(float a) {
    auto rr = __builtin_amdgcn_permlane32_swap(__float_as_uint(a), __float_as_uint(a), false, false);
    return max2f(__uint_as_float(rr[0]), __uint_as_float(rr[1]));
}
__device__ __forceinline__ float halfsum(float x) {
    auto rr = __builtin_amdgcn_permlane32_swap(__float_as_uint(x), __float_as_uint(x), false, false);
    return __uint_as_float(rr[0]) + __uint_as_float(rr[1]);
}
#define GLDS16(gsrc, ldsdst) __builtin_amdgcn_global_load_lds((const unsigned*)(gsrc), (LAS unsigned*)(ldsdst), 16, 0, 0)
__device__ __forceinline__ void glds16_asm(const void* gsrc, unsigned lds_dst) {
    unsigned keep;
    asm volatile("s_mov_b32 %0, m0\n\ts_mov_b32 m0, %2\n\ts_nop 0\n\tglobal_load_lds_dwordx4 %1, off\n\ts_mov_b32 m0, %0" : "=&s"(keep) : "v"(gsrc), "s"(lds_dst) : "memory");
}
#define GLDS16A(gsrc, ldsdst) glds16_asm((const void*)(gsrc), (unsigned)__builtin_amdgcn_readfirstlane((int)(unsigned)(uintptr_t)(ldsdst)))
#define WAIT_VM0_BAR() do { asm volatile("s_waitcnt vmcnt(0)" ::: "memory"); __builtin_amdgcn_s_barrier(); asm volatile("" ::: "memory"); } while (0)

template <int THR>
__device__ __forceinline__ bool softmax_tile(f32x16& p0, f32x16& p1, float& m_run, float& l_run, LAS float* wsf, int r32, int hi) {
    const float rm = rowmax32(p0, p1);
    const bool resc = __any(rm > m_run + (float)THR);
    if (resc) {
        const float mn = max2f(m_run, rm); const float f = fast_exp2(m_run - mn); m_run = mn; l_run *= f;
        if (hi == 0) wsf[r32] = f;
    }
    const float mm = m_run; float s = 0.f;
#pragma unroll
    for (int r = 0; r < 16; ++r) { p0[r] = fast_exp2(p0[r] - mm); p1[r] = fast_exp2(p1[r] - mm); s += p0[r] + p1[r]; }
    l_run += s;
    return resc;
}
template <int THR>
__device__ __forceinline__ bool softmax_rel(f32x16& p0, f32x16& p1, float& m_run, float& l_run, bool first, LAS float* wsf, int r32, int hi) {
    const float rm = rowmax32(p0, p1);
    const bool resc = first || __any(rm > (float)THR);
    if (resc) {
        const float dl = first ? rm : fmaxf(rm, 0.f); m_run += dl;
        const float f = first ? 0.f : fast_exp2(-dl); l_run *= f;
        if (hi == 0) wsf[r32] = f;
#pragma unroll
        for (int r = 0; r < 16; ++r) { p0[r] -= dl; p1[r] -= dl; }
    }
    float s = 0.f;
#pragma unroll
    for (int r = 0; r < 16; ++r) { p0[r] = fast_exp2(p0[r]); p1[r] = fast_exp2(p1[r]); s += p0[r] + p1[r]; }
    l_run += s;
    return resc;
}
__device__ __forceinline__ bf16x8 pack8(const f32x16& p, int b) {
    u32x4 w; w.x = cvtpk(p[b], p[b + 1]); w.y = cvtpk(p[b + 2], p[b + 3]); w.z = cvtpk(p[b + 4], p[b + 5]); w.w = cvtpk(p[b + 6], p[b + 7]);
    return __builtin_bit_cast(bf16x8, w);
}
#define MFMA32(a, b, c) __builtin_amdgcn_mfma_f32_32x32x16_bf16((a), (b), (c), 0, 0, 0)

template <int THR>
__device__ __forceinline__ void diff_unit(int b, int h, int qb, bf16_t* Z, const float* gsub, float lam, LAS unsigned char* lds) {
    const int tid = threadIdx.x; int lane_ = tid & 63; asm volatile("" : "+v"(lane_));
    const int lane = lane_, r32 = lane & 31, hi = lane >> 5;
    const int w = __builtin_amdgcn_readfirstlane(tid >> 6);
    const size_t rowbase = (size_t)b * SEQ;
    const int q0 = qb * 256 + w * 32;
    LAS unsigned char* Qw = lds + 67584 + w * 8704;
    { const bf16_t* qg = Z + (rowbase + q0) * ZP + h * 128;
      int l0 = threadIdx.x & 63; asm volatile("" : "+v"(l0));
      const unsigned goff = (unsigned)((l0 >> 4) * ZP + (l0 & 15) * 8), loff = (unsigned)((l0 >> 4) * 272 + (l0 & 15) * 16);
      const bf16_t* qgl = qg + goff; LAS unsigned char* qwl = Qw + loff;
#pragma unroll 1
      for (int j = 0; j < 8; ++j) { *(LAS u32x4*)qwl = *(const u32x4*)qgl; qgl += 4 * ZP; qwl += 4 * 272; } }
    const LAS unsigned char* qrd = Qw + r32 * 272 + hi * 16;
    const int krow = 8 * w + (lane >> 3);
    const bf16_t* kbase = Z + rowbase * ZP + ZC_KA + h * 128;
    const bf16_t* vbase = Z + rowbase * ZP + ZC_VA + h * 128;
    const unsigned koff = (unsigned)(krow * ZP + (((lane & 7) ^ ((krow >> 1) & 7)) << 3));
    const unsigned voff = (unsigned)((4 * w + (lane >> 4)) * ZP + (((lane & 15) ^ (((lane >> 4) & 3) << 2)) << 3));
    const unsigned wl = (unsigned)w * 1024u;
#define DIFF_ISSUE(t, buf) do { const bf16_t* _k = kbase + (size_t)(t) * 64 * ZP; const bf16_t* _v = vbase + (size_t)(t) * 64 * ZP; LAS unsigned char* _b = lds + (buf) * 32768; \
        GLDS16(_k + koff, _b + wl); GLDS16(_k + 64 + koff, _b + 8192 + wl); GLDS16(_v + voff, _b + 16384 + wl); GLDS16(_v + (size_t)32 * ZP + voff, _b + 16384 + 8192 + wl); } while (0)
    const int swz = (r32 >> 1) & 7;
    int kaddr[4];
#pragma unroll
    for (int d0 = 0; d0 < 4; ++d0) kaddr[d0] = r32 * 128 + (((2 * d0 + hi) ^ swz) << 4);
    const int q4 = (lane >> 2) & 3, gb = (lane >> 4) & 1, p4 = lane & 3;
    int vaddr[4];
#pragma unroll
    for (int d = 0; d < 4; ++d) vaddr[d] = (4 * hi + q4) * 256 + ((d ^ q4) << 6) + 32 * gb + 8 * p4;
    LAS float* wsf = (LAS float*)(lds + 65536) + w * 64;

    float m_init = 0.f; asm volatile("" : "+v"(m_init));
    float m_run[2] = {m_init, m_init}, l_run[2] = {0.f, 0.f};
    f32x16 o[2][4];
#pragma unroll
    for (int c = 0; c < 2; ++c)
#pragma unroll
        for (int d = 0; d < 4; ++d)
#pragma unroll
            for (int r = 0; r < 16; ++r) o[c][d][r] = 0.f;
    constexpr int NT = SEQ / 64;
    DIFF_ISSUE(0, 0);
    if (w < 4) __builtin_amdgcn_s_setprio(1);
    for (int t = 0; t < NT; ++t) {
        WAIT_VM0_BAR();
        if (t + 1 < NT) DIFF_ISSUE(t + 1, (t + 1) & 1);
        const LAS unsigned char* B = lds + (t & 1) * 32768;
        bf16x8 pa[2][4]; bool resc[2];
#pragma unroll
        for (int c = 0; c < 2; ++c) {
            f32x16 p0, p1, negm;
            { const float nm = -m_run[c];
#pragma unroll
              for (int r = 0; r < 16; ++r) negm[r] = nm; }
#pragma unroll
            for (int d0 = 0; d0 < 4; ++d0) {
                const bf16x8 k0 = *(const LAS bf16x8*)(B + c * 8192 + kaddr[d0]);
                const bf16x8 k1 = *(const LAS bf16x8*)(B + c * 8192 + 4096 + kaddr[d0]);
                const bf16x8 qv = *(const LAS bf16x8*)(qrd + c * 128 + d0 * 32);
                if (d0 == 0) { p0 = MFMA32(k0, qv, negm); p1 = MFMA32(k1, qv, negm); } else { p0 = MFMA32(k0, qv, p0); p1 = MFMA32(k1, qv, p1); }
                asm volatile("" ::: "memory");
            }
            resc[c] = softmax_rel<THR>(p0, p1, m_run[c], l_run[c], t == 0, wsf + c * 32, r32, hi);
            pa[c][0] = pack8(p0, 0); pa[c][1] = pack8(p0, 8); pa[c][2] = pack8(p1, 0); pa[c][3] = pack8(p1, 8);
        }
#pragma unroll
        for (int c = 0; c < 2; ++c)
            if (resc[c]) {
#pragma unroll
                for (int r = 0; r < 16; ++r) { const float f = wsf[c * 32 + crow(r, hi)];
#pragma unroll
                    for (int d = 0; d < 4; ++d) o[c][d][r] *= f; }
            }
#pragma unroll
        for (int s = 0; s < 4; ++s)
#pragma unroll
            for (int d = 0; d < 4; ++d) {
                const s16x4 lo = vtr(B + 16384 + vaddr[d] + s * 4096), hi4 = vtr(B + 16384 + vaddr[d] + s * 4096 + 2048);
                const bf16x8 vf = (bf16x8){lo[0], lo[1], lo[2], lo[3], hi4[0], hi4[1], hi4[2], hi4[3]};
                o[0][d] = MFMA32(pa[0][s], vf, o[0][d]); o[1][d] = MFMA32(pa[1][s], vf, o[1][d]);
                if (d & 1) asm volatile("" ::: "memory");
            }
    }
#undef DIFF_ISSUE
    __builtin_amdgcn_s_setprio(0);
    { const float l0 = halfsum(l_run[0]), l1 = halfsum(l_run[1]);
      if (hi == 0) { wsf[r32] = fast_rcp(l0); wsf[32 + r32] = lam * fast_rcp(l1); } }
    int le = threadIdx.x & 63; asm volatile("" : "+v"(le));
    const int r32e = le & 31, hie = le >> 5;
    const LAS float* wse = (const LAS float*)(lds + 65536) + w * 64 + 4 * hie;
    float gs[4];
#pragma unroll
    for (int d = 0; d < 4; ++d) gs[d] = gsub[d * 32 + r32e] * (1.f - LAMBDA_INIT);
    bf16_t* op = Z + (rowbase + q0) * ZP + h * 128;
    const unsigned ooff = (unsigned)(4 * hie * ZP + r32e);
#pragma unroll
    for (int r = 0; r < 16; ++r) {
        const int qc = (r & 3) + 8 * (r >> 2); const float i1 = wse[qc], i2 = wse[32 + qc];
        float v[4]; float ss = 0.f;
#pragma unroll
        for (int d = 0; d < 4; ++d) { v[d] = o[0][d][r] * i1 - o[1][d][r] * i2; ss += v[d] * v[d]; }
        ss += __shfl_xor(ss, 1); ss += __shfl_xor(ss, 2); ss += __shfl_xor(ss, 4); ss += __shfl_xor(ss, 8); ss += __shfl_xor(ss, 16);
        const float rstd = 1.0f / sqrtf(ss * (1.f / 128.f) + EPS);
#pragma unroll
        for (int d = 0; d < 4; ++d) { const unsigned pk = cvtpk(v[d] * rstd * gs[d], 0.f); op[ooff + (unsigned)(qc * ZP + d * 32)] = (bf16_t)(pk & 0xffffu); }
    }
}

template <int DIL>
__device__ __forceinline__ void dil_group(int g, size_t rowbase, int hg, int qb, const bf16_t* Z, LAS unsigned char* lds, float& m_run, float& l_run, f32x16 (&o)[2],
                                          int lane, int r32, int hi, int w, LAS float* wsf) {
    const int head = 4 * g + hg;
    const int blk = qb * 256, tq = blk + 16 * (r32 >> 1) + 2 * w + (r32 & 1);
    bf16x8 qf[4];
    { const bf16_t* qp = Z + (rowbase + tq) * ZP + ZC_QD + head * 64 + hi * 8;
#pragma unroll
      for (int d0 = 0; d0 < 4; ++d0) qf[d0] = *(const bf16x8*)(qp + d0 * 16); }
    f32x16 am;
#pragma unroll
    for (int r = 0; r < 16; ++r) am[r] = ((((r & 3) + 8 * (r >> 2) + 4 * hi - tq) & (DIL - 1)) == 0) ? 0.f : -INFINITY;
    int kstart = qb * 256 - 64 * DIL; if (kstart < 0) kstart = 0;
    int kend = qb * 256 + 256 + 64 * DIL; if (kend > SEQ) kend = SEQ;
    const int NT = (kend - kstart) >> 6;
    const int krow = 8 * w + (lane >> 3);
    const bf16_t* ksrc = Z + (rowbase + kstart + krow) * ZP + ZC_KD + head * 64 + (((lane & 7) ^ ((krow >> 1) & 7)) << 3);
    const bf16_t* vsrc = Z + (rowbase + kstart + krow) * ZP + ZC_VD + head * 64 + (((lane & 7) ^ (((krow >> 1) & 1) << 2)) << 3);
    const unsigned wl = (unsigned)w * 1024u;
#define DIL_ISSUE(t, buf) do { const size_t _o = (size_t)(t) * 64 * ZP; LAS unsigned char* _b = lds + (buf) * 16384; GLDS16(ksrc + _o, _b + wl); GLDS16(vsrc + _o, _b + 8192 + wl); } while (0)
    const int swz = (r32 >> 1) & 7;
    int kaddr[4];
#pragma unroll
    for (int d0 = 0; d0 < 4; ++d0) kaddr[d0] = r32 * 128 + (((2 * d0 + hi) ^ swz) << 4);
    const int q4 = (lane >> 2) & 3, gb = (lane >> 4) & 1, p4 = lane & 3;
    int vaddr[2];
#pragma unroll
    for (int d = 0; d < 2; ++d) vaddr[d] = (4 * hi + q4) * 128 + ((d ^ (q4 >> 1)) << 6) + 32 * gb + 8 * p4;
    __syncthreads();
    asm volatile("s_waitcnt vmcnt(0)" ::: "memory");
#pragma unroll
    for (int i = 0; i < 6; ++i) if (i < NT) DIL_ISSUE(i, i);
    for (int t = 0; t < NT; ++t) {
        { const int rem = NT - 1 - t;
          if (rem >= 5) asm volatile("s_waitcnt vmcnt(10)" ::: "memory"); else if (rem == 4) asm volatile("s_waitcnt vmcnt(8)" ::: "memory");
          else if (rem == 3) asm volatile("s_waitcnt vmcnt(6)" ::: "memory"); else if (rem == 2) asm volatile("s_waitcnt vmcnt(4)" ::: "memory");
          else if (rem == 1) asm volatile("s_waitcnt vmcnt(2)" ::: "memory"); else asm volatile("s_waitcnt vmcnt(0)" ::: "memory"); }
        __builtin_amdgcn_s_barrier(); asm volatile("" ::: "memory");
        if (t + 6 < NT) DIL_ISSUE(t + 6, (t + 6) & 7);
        const int k0 = kstart + t * 64;
        {
            const LAS unsigned char* B = lds + (t & 7) * 16384;
            f32x16 p0, p1;
#pragma unroll
            for (int d0 = 0; d0 < 4; ++d0) {
                const bf16x8 ka = *(const LAS bf16x8*)(B + kaddr[d0]);
                const bf16x8 kb = *(const LAS bf16x8*)(B + 4096 + kaddr[d0]);
                if (d0 == 0) { p0 = MFMA32(ka, qf[d0], am); p1 = MFMA32(kb, qf[d0], am); }
                else { p0 = MFMA32(ka, qf[d0], p0); p1 = MFMA32(kb, qf[d0], p1); }
            }
            const bool interior = (k0 + 63 - blk <= 64 * DIL) && (blk + 255 - k0 <= 64 * DIL);
            if (!interior) {
                const int dd = k0 + 4 * hi - tq;
#pragma unroll
                for (int r = 0; r < 16; ++r) {
                    const int d0_ = dd + (r & 3) + 8 * (r >> 2), d1_ = d0_ + 32;
                    const bool v0 = (d0_ <= 64 * DIL) && (d0_ >= -64 * DIL);
                    const bool v1 = (d1_ <= 64 * DIL) && (d1_ >= -64 * DIL);
                    p0[r] = v0 ? p0[r] : -INFINITY; p1[r] = v1 ? p1[r] : -INFINITY;
                }
            }
            const bool resc = softmax_tile<8>(p0, p1, m_run, l_run, wsf, r32, hi);
            const bf16x8 pa0 = pack8(p0, 0), pa1 = pack8(p0, 8), pa2 = pack8(p1, 0), pa3 = pack8(p1, 8);
            if (resc) {
#pragma unroll
                for (int r = 0; r < 16; ++r) { const float f = wsf[crow(r, hi)]; o[0][r] *= f; o[1][r] *= f; }
            }
#pragma unroll
            for (int d = 0; d < 2; ++d) {
                const LAS unsigned char* vb = B + 8192 + vaddr[d];
                s16x4 lo, h4; bf16x8 vf;
                lo = vtr(vb + 0 * 2048); h4 = vtr(vb + 0 * 2048 + 1024); vf = (bf16x8){lo[0], lo[1], lo[2], lo[3], h4[0], h4[1], h4[2], h4[3]}; o[d] = MFMA32(pa0, vf, o[d]);
                lo = vtr(vb + 1 * 2048); h4 = vtr(vb + 1 * 2048 + 1024); vf = (bf16x8){lo[0], lo[1], lo[2], lo[3], h4[0], h4[1], h4[2], h4[3]}; o[d] = MFMA32(pa1, vf, o[d]);
                lo = vtr(vb + 2 * 2048); h4 = vtr(vb + 2 * 2048 + 1024); vf = (bf16x8){lo[0], lo[1], lo[2], lo[3], h4[0], h4[1], h4[2], h4[3]}; o[d] = MFMA32(pa2, vf, o[d]);
                lo = vtr(vb + 3 * 2048); h4 = vtr(vb + 3 * 2048 + 1024); vf = (bf16x8){lo[0], lo[1], lo[2], lo[3], h4[0], h4[1], h4[2], h4[3]}; o[d] = MFMA32(pa3, vf, o[d]);
            }
        }
    }
#undef DIL_ISSUE
}
__device__ __forceinline__ void dil_group4(size_t rowbase, int hg, int qb, const bf16_t* Z, LAS unsigned char* lds, float& m_run, float& l_run, f32x16 (&o)[2],
                                           int lane, int r32, int hi, int w, LAS float* wsf) {
    const int head = 4 + hg;
    const int blk = qb * 256, tq = blk + 16 * (r32 >> 1) + 2 * w + (r32 & 1);
    bf16x8 qf[4];
    { const bf16_t* qp = Z + (rowbase + tq) * ZP + ZC_QD + head * 64 + hi * 8;
#pragma unroll
      for (int d0 = 0; d0 < 4; ++d0) qf[d0] = *(const bf16x8*)(qp + d0 * 16); }
    f32x16 am;
#pragma unroll
    for (int r = 0; r < 16; ++r) am[r] = (((r ^ r32) & 1) == 0) ? 0.f : -INFINITY;
    int kstart = blk - 256; if (kstart < 0) kstart = 0;
    int kend = blk + 512; if (kend > SEQ) kend = SEQ;
    const int NST = (kend - kstart) >> 7;
    const int X = w & 1;
    const int kkl = 8 * w + (lane >> 3);
    const int tokoff = 4 * (kkl >> 1) + (kkl & 1);
    const bf16_t* kbase = Z + (rowbase + kstart + tokoff) * ZP + ZC_KD + head * 64 + (((lane & 7) ^ ((kkl >> 1) & 7)) << 3);
    const bf16_t* vbase = Z + (rowbase + kstart + tokoff) * ZP + ZC_VD + head * 64 + (((lane & 7) ^ (((kkl >> 1) & 1) << 2)) << 3);
    const unsigned wl = (unsigned)w * 1024u;
#define D4_ISSUE(st, slot) do { const size_t _o = (size_t)(st) * 128 * ZP; LAS unsigned char* _b = lds + (slot) * 32768; \
        GLDS16A(kbase + _o, _b + wl); GLDS16A(vbase + _o, _b + 8192 + wl); \
        GLDS16A(kbase + _o + (size_t)2 * ZP, _b + 16384 + wl); GLDS16A(vbase + _o + (size_t)2 * ZP, _b + 16384 + 8192 + wl); } while (0)
    const int swz = (r32 >> 1) & 7;
    int kaddr[4];
#pragma unroll
    for (int d0 = 0; d0 < 4; ++d0) kaddr[d0] = r32 * 128 + (((2 * d0 + hi) ^ swz) << 4);
    const int q4 = (lane >> 2) & 3, gb = (lane >> 4) & 1, p4 = lane & 3;
    int vaddr[2];
#pragma unroll
    for (int d = 0; d < 2; ++d) vaddr[d] = (4 * hi + q4) * 128 + ((d ^ (q4 >> 1)) << 6) + 32 * gb + 8 * p4;
    __syncthreads();
    asm volatile("s_waitcnt vmcnt(0)" ::: "memory");
#pragma unroll
    for (int i = 0; i < 3; ++i) if (i < NST) D4_ISSUE(i, i);
    for (int st = 0; st < NST; ++st) {
        { const int rem = NST - 1 - st;
          if (rem >= 2) asm volatile("s_waitcnt vmcnt(8)" ::: "memory"); else if (rem == 1) asm volatile("s_waitcnt vmcnt(4)" ::: "memory"); else asm volatile("s_waitcnt vmcnt(0)" ::: "memory"); }
        __builtin_amdgcn_s_barrier(); asm volatile("" ::: "memory");
        if (st + 3 < NST) D4_ISSUE(st + 3, (st + 3) & 3);
        const LAS unsigned char* B = lds + (st & 3) * 32768 + X * 16384;
        const int dT = kstart + st * 128 - blk;
        f32x16 p0, p1;
#pragma unroll
        for (int d0 = 0; d0 < 4; ++d0) {
            const bf16x8 ka = *(const LAS bf16x8*)(B + kaddr[d0]);
            const bf16x8 kb = *(const LAS bf16x8*)(B + 4096 + kaddr[d0]);
            if (d0 == 0) { p0 = MFMA32(ka, qf[d0], am); p1 = MFMA32(kb, qf[d0], am); }
            else { p0 = MFMA32(ka, qf[d0], p0); p1 = MFMA32(kb, qf[d0], p1); }
        }
        if (dT < -2 || dT > 132) {
            const int dd = dT - 16 * (r32 >> 1) + 2 * X - 2 * w;
#pragma unroll
            for (int r = 0; r < 16; ++r) { const int kk = (r & 3) + 8 * (r >> 2) + 4 * hi; const int d0_ = dd + 4 * (kk >> 1), d1_ = d0_ + 64;
                p0[r] = (d0_ <= 256 && d0_ >= -256) ? p0[r] : -INFINITY; p1[r] = (d1_ <= 256 && d1_ >= -256) ? p1[r] : -INFINITY; }
        }
        const bool resc = softmax_tile<8>(p0, p1, m_run, l_run, wsf, r32, hi);
        const bf16x8 pa0 = pack8(p0, 0), pa1 = pack8(p0, 8), pa2 = pack8(p1, 0), pa3 = pack8(p1, 8);
        if (resc) {
#pragma unroll
            for (int r = 0; r < 16; ++r) { const float f = wsf[crow(r, hi)]; o[0][r] *= f; o[1][r] *= f; }
        }
#pragma unroll
        for (int d = 0; d < 2; ++d) {
            const LAS unsigned char* vb = B + 8192 + vaddr[d];
            s16x4 lo, h4; bf16x8 vf;
            lo = vtr(vb + 0 * 2048); h4 = vtr(vb + 0 * 2048 + 1024); vf = (bf16x8){lo[0], lo[1], lo[2], lo[3], h4[0], h4[1], h4[2], h4[3]}; o[d] = MFMA32(pa0, vf, o[d]);
            lo = vtr(vb + 1 * 2048); h4 = vtr(vb + 1 * 2048 + 1024); vf = (bf16x8){lo[0], lo[1], lo[2], lo[3], h4[0], h4[1], h4[2], h4[3]}; o[d] = MFMA32(pa1, vf, o[d]);
            lo = vtr(vb + 2 * 2048); h4 = vtr(vb + 2 * 2048 + 1024); vf = (bf16x8){lo[0], lo[1], lo[2], lo[3], h4[0], h4[1], h4[2], h4[3]}; o[d] = MFMA32(pa2, vf, o[d]);
            lo = vtr(vb + 3 * 2048); h4 = vtr(vb + 3 * 2048 + 1024); vf = (bf16x8){lo[0], lo[1], lo[2], lo[3], h4[0], h4[1], h4[2], h4[3]}; o[d] = MFMA32(pa3, vf, o[d]);
        }
    }
#undef D4_ISSUE
}
__device__ __forceinline__ void dil_group16(size_t rowbase, int hg, int qb, const bf16_t* Z, LAS unsigned char* lds, float& m_run, float& l_run, f32x16 (&o)[2],
                                            int lane, int r32, int hi, int w, LAS float* wsf) {
    const int head = 8 + hg;
    const int blk = qb * 256, tq = blk + 16 * (r32 >> 1) + 2 * w + (r32 & 1);
    bf16x8 qf[4];
    { const bf16_t* qp = Z + (rowbase + tq) * ZP + ZC_QD + head * 64 + hi * 8;
#pragma unroll
      for (int d0 = 0; d0 < 4; ++d0) qf[d0] = *(const bf16x8*)(qp + d0 * 16); }
    f32x16 am;
#pragma unroll
    for (int r = 0; r < 16; ++r) am[r] = (((r ^ r32) & 1) == 0) ? 0.f : -INFINITY;
    int kstart = blk - 1024; if (kstart < 0) kstart = 0;
    int kend = blk + 256 + 1024; if (kend > SEQ) kend = SEQ;
    const int NST = (kend - kstart) >> 8;
    const int i4 = lane >> 4;
    const int rowoff = 16 * i4 + 2 * w + ((lane >> 3) & 1);
    const int kch = (lane & 7) ^ i4;
    const bf16_t* kbase = Z + (rowbase + kstart + rowoff) * ZP + ZC_KD + head * 64;
    const bf16_t* vbase = Z + (rowbase + kstart + rowoff) * ZP + ZC_VD + head * 64 + (((lane & 7) ^ ((i4 & 1) << 2)) << 3);
    LAS unsigned char* reg = lds + w * 16384;
#define D16_ISSUE(st, buf) do { const size_t _o = (size_t)(st) * 256 * ZP; LAS unsigned char* _b = reg + (buf) * 8192; \
        _Pragma("unroll") for (int j = 0; j < 4; ++j) { GLDS16A(kbase + _o + (size_t)j * 64 * ZP + (((j & 1) ? (kch ^ 4) : kch) << 3), _b + j * 1024); \
                                                        GLDS16A(vbase + _o + (size_t)j * 64 * ZP, _b + 4096 + j * 1024); } } while (0)
    const int swz = (r32 >> 1) & 7;
    int kaddr[4];
#pragma unroll
    for (int d0 = 0; d0 < 4; ++d0) kaddr[d0] = r32 * 128 + (((2 * d0 + hi) ^ swz) << 4);
    const int q4 = (lane >> 2) & 3, gb = (lane >> 4) & 1, p4 = lane & 3;
    int vaddr[2];
#pragma unroll
    for (int d = 0; d < 2; ++d) vaddr[d] = (4 * hi + q4) * 128 + ((d ^ (q4 >> 1)) << 6) + 32 * gb + 8 * p4;
    __syncthreads();
    asm volatile("s_waitcnt vmcnt(0)" ::: "memory");
    D16_ISSUE(0, 0);
    for (int st = 0; st < NST; ++st) {
        if (st + 1 < NST) { D16_ISSUE(st + 1, (st + 1) & 1); asm volatile("s_waitcnt vmcnt(8)" ::: "memory"); }
        else asm volatile("s_waitcnt vmcnt(0)" ::: "memory");
        const LAS unsigned char* B = reg + (st & 1) * 8192;
        const int dT = kstart + st * 256 - blk;
        f32x16 p0;
#pragma unroll
        for (int d0 = 0; d0 < 4; ++d0) { const bf16x8 ka = *(const LAS bf16x8*)(B + kaddr[d0]);
            if (d0 == 0) p0 = MFMA32(ka, qf[d0], am); else p0 = MFMA32(ka, qf[d0], p0); }
        if (dT < -768 || dT > 768) {
#pragma unroll
            for (int r = 0; r < 16; ++r) { const int kk = (r & 3) + 8 * (r >> 2) + 4 * hi; const int d = dT + 16 * ((kk >> 1) - (r32 >> 1));
                p0[r] = (d <= 1024 && d >= -1024) ? p0[r] : -INFINITY; }
        }
        float rm = max3f(p0[0], p0[1], p0[2]);
#pragma unroll
        for (int r = 3; r < 15; r += 2) rm = max3f(rm, p0[r], p0[r + 1]);
        rm = halfmax(max2f(rm, p0[15]));
        const bool resc = __any(rm > m_run + 8.f);
        if (resc) { const float mn = max2f(m_run, rm); const float f = fast_exp2(m_run - mn); m_run = mn; l_run *= f; if (hi == 0) wsf[r32] = f; }
        const float mm = m_run; float sm = 0.f;
#pragma unroll
        for (int r = 0; r < 16; ++r) { p0[r] = fast_exp2(p0[r] - mm); sm += p0[r]; }
        l_run += sm;
        const bf16x8 pa0 = pack8(p0, 0), pa1 = pack8(p0, 8);
        if (resc) {
#pragma unroll
            for (int r = 0; r < 16; ++r) { const float f = wsf[crow(r, hi)]; o[0][r] *= f; o[1][r] *= f; }
        }
#pragma unroll
        for (int d = 0; d < 2; ++d) {
            const LAS unsigned char* vb = B + 4096 + vaddr[d];
            s16x4 lo, h4; bf16x8 vf;
            lo = vtr(vb); h4 = vtr(vb + 1024); vf = (bf16x8){lo[0], lo[1], lo[2], lo[3], h4[0], h4[1], h4[2], h4[3]}; o[d] = MFMA32(pa0, vf, o[d]);
            lo = vtr(vb + 2048); h4 = vtr(vb + 2048 + 1024); vf = (bf16x8){lo[0], lo[1], lo[2], lo[3], h4[0], h4[1], h4[2], h4[3]}; o[d] = MFMA32(pa1, vf, o[d]);
        }
    }
#undef D16_ISSUE
}
__device__ __forceinline__ void dil_unit(int b, int hg, int qb, bf16_t* Z, LAS unsigned char* lds) {
    const int tid = threadIdx.x, lane = tid & 63, r32 = lane & 31, hi = lane >> 5;
    const int w = __builtin_amdgcn_readfirstlane(tid >> 6);
    const size_t rowbase = (size_t)b * SEQ;
    LAS float* wsf = (LAS float*)(lds + 131072) + w * 64;
    float m_run = -1e30f, l_run = 0.f;
    f32x16 o[2];
#pragma unroll
    for (int d = 0; d < 2; ++d)
#pragma unroll
        for (int r = 0; r < 16; ++r) o[d][r] = 0.f;
    dil_group<1>(0, rowbase, hg, qb, Z, lds, m_run, l_run, o, lane, r32, hi, w, wsf);
    dil_group4(rowbase, hg, qb, Z, lds, m_run, l_run, o, lane, r32, hi, w, wsf);
    dil_group16(rowbase, hg, qb, Z, lds, m_run, l_run, o, lane, r32, hi, w, wsf);
    const float lt = halfsum(l_run);
    if (hi == 0) wsf[r32] = fast_rcp(lt);
    bf16_t* op = Z + (rowbase + qb * 256 + 2 * w) * ZP + ZC_QD + hg * 64 + r32;
#pragma unroll
    for (int r = 0; r < 16; ++r) { const int q = crow(r, hi); const float il = wsf[q]; const int trow = 16 * (q >> 1) + (q & 1);
#pragma unroll
        for (int d = 0; d < 2; ++d) { const unsigned pk = cvtpk(o[d][r] * il, 0.f); op[(size_t)trow * ZP + d * 32] = (bf16_t)(pk & 0xffffu); } }
    __syncthreads();
}

__device__ __forceinline__ void ld_f32_row(const float* row, int lane, f32x4 (&v)[4]) {
    const f32x4* p = (const f32x4*)row + lane;
#pragma unroll
    for (int j = 0; j < 4; ++j) v[j] = p[64 * j];
}
__device__ __forceinline__ void ld_bf16_row(const bf16_t* row, int lane, f32x4 (&v)[4]) {
    const u32x2* p = (const u32x2*)row + lane;
#pragma unroll
    for (int j = 0; j < 4; ++j) { const u32x2 w = p[64 * j]; v[j] = (f32x4){bflo(w.x), bfhi(w.x), bflo(w.y), bfhi(w.y)}; }
}
__device__ __forceinline__ void st_f32_row(float* row, int lane, const f32x4 (&v)[4]) {
    f32x4* p = (f32x4*)row + lane;
#pragma unroll
    for (int j = 0; j < 4; ++j) p[64 * j] = v[j];
}
__device__ __forceinline__ void st_bf16_row(bf16_t* row, int lane, const f32x4 (&v)[4]) {
    u32x2* p = (u32x2*)row + lane;
#pragma unroll
    for (int j = 0; j < 4; ++j) { u32x2 w; w.x = cvtpk(v[j][0], v[j][1]); w.y = cvtpk(v[j][2], v[j][3]); p[64 * j] = w; }
}
__device__ __forceinline__ float row_rstd(const f32x4 (&v)[4]) {
    float s = 0.f;
#pragma unroll
    for (int j = 0; j < 4; ++j) s += (v[j][0] * v[j][0] + v[j][1] * v[j][1]) + (v[j][2] * v[j][2] + v[j][3] * v[j][3]);
    return 1.0f / sqrtf(wave_sum(s) * (1.f / DM) + EPS);
}
__device__ __forceinline__ void add_normed(f32x4 (&acc)[4], const f32x4 (&y)[4], const float* g, int lane, float scale) {
    const float r = row_rstd(y) * scale; f32x4 gv[4]; ld_f32_row(g, lane, gv);
#pragma unroll
    for (int j = 0; j < 4; ++j) acc[j] = acc[j] + y[j] * r * gv[j];
}
__device__ __forceinline__ void norm_to_bf16(const f32x4 (&x)[4], const float* g, int lane, bf16_t* orow) {
    const float r = row_rstd(x); f32x4 gv[4]; ld_f32_row(g, lane, gv); f32x4 t[4];
#pragma unroll
    for (int j = 0; j < 4; ++j) t[j] = x[j] * r * gv[j];
    st_bf16_row(orow, lane, t);
}

__device__ __forceinline__ int gu_map(int n0) { return n0 < DFF ? (((n0 >> 7) << 8) + (n0 & 127)) : ((((n0 - DFF) >> 7) << 8) + 128 + ((n0 - DFF) & 127)); }
template <bool GU>
__device__ __forceinline__ void transpose_item(const float* W, int K, int N, bf16_t* WT, LAS float* scr, int item, int lane) {
    const int nblk = N / 32, kb = item / nblk, nb = item % nblk, k0 = 64 * kb, n0 = 32 * nb;
    const int r0 = GU ? gu_map(n0) : n0;
#pragma unroll 8
    for (int i = 0; i < 32; ++i) { const int kk = 2 * i + (lane >> 5); scr[kk * 33 + (lane & 31)] = W[(size_t)(k0 + kk) * N + n0 + (lane & 31)]; }
    asm volatile("s_waitcnt lgkmcnt(0)" ::: "memory");
    const int c = lane & 7;
#pragma unroll
    for (int j = 0; j < 4; ++j) { const int n = (lane >> 3) + 8 * j; const LAS float* s = scr + (8 * c) * 33 + n;
        u32x4 o; o.x = cvtpk(s[0 * 33], s[1 * 33]); o.y = cvtpk(s[2 * 33], s[3 * 33]); o.z = cvtpk(s[4 * 33], s[5 * 33]); o.w = cvtpk(s[6 * 33], s[7 * 33]);
        *(u32x4*)(WT + (size_t)(r0 + n) * K + k0 + 8 * c) = o; }
    asm volatile("s_waitcnt lgkmcnt(0)" ::: "memory");
}
__device__ __forceinline__ void sincos_d(double a, float& c, float& s) {
    const double TWO_PI = 6.283185307179586476925, INV_2PI = 0.15915494309189533577;
    const double k = __builtin_rint(a * INV_2PI); const double r = a - k * TWO_PI, r2 = r * r;
    double sp = -1.0 / 121645100408832000.0;
    sp = sp * r2 + 1.0 / 355687428096000.0; sp = sp * r2 - 1.0 / 1307674368000.0; sp = sp * r2 + 1.0 / 6227020800.0; sp = sp * r2 - 1.0 / 39916800.0;
    sp = sp * r2 + 1.0 / 362880.0; sp = sp * r2 - 1.0 / 5040.0; sp = sp * r2 + 1.0 / 120.0; sp = sp * r2 - 1.0 / 6.0; sp = sp * r2 + 1.0;
    double cp = 1.0 / 2432902008176640000.0;
    cp = cp * r2 - 1.0 / 6402373705728000.0; cp = cp * r2 + 1.0 / 20922789888000.0; cp = cp * r2 - 1.0 / 87178291200.0; cp = cp * r2 + 1.0 / 479001600.0;
    cp = cp * r2 - 1.0 / 3628800.0; cp = cp * r2 + 1.0 / 40320.0; cp = cp * r2 - 1.0 / 720.0; cp = cp * r2 + 1.0 / 24.0; cp = cp * r2 - 0.5; cp = cp * r2 + 1.0;
    s = (float)(sp * r); c = (float)cp;
}

constexpr int N_PHASES = 12;

__device__ __forceinline__ bool ph_in(int k) {
    kargs_t p = (kargs_t)__builtin_amdgcn_kernarg_segment_ptr(); asm volatile("" : "+s"(p)); return p->ph_lo <= k && k < p->ph_hi;
}
__device__ __forceinline__ void grid_bar(unsigned* bar, unsigned G) {
    asm volatile("s_waitcnt vmcnt(0)" ::: "memory");
    __syncthreads();
    if (threadIdx.x == 0) {
        __builtin_amdgcn_fence(__ATOMIC_RELEASE, "agent");
        const unsigned gen = __hip_atomic_load(bar + 64, __ATOMIC_RELAXED, __HIP_MEMORY_SCOPE_AGENT);
        const unsigned old = __hip_atomic_fetch_add(bar, 1u, __ATOMIC_RELAXED, __HIP_MEMORY_SCOPE_AGENT);
        if (old == G - 1u) {
            __hip_atomic_store(bar, 0u, __ATOMIC_RELAXED, __HIP_MEMORY_SCOPE_AGENT);
            __hip_atomic_fetch_add(bar + 64, 1u, __ATOMIC_RELEASE, __HIP_MEMORY_SCOPE_AGENT);
        } else {
            unsigned spins = 0;
            while (__hip_atomic_load(bar + 64, __ATOMIC_RELAXED, __HIP_MEMORY_SCOPE_AGENT) == gen) { __builtin_amdgcn_s_sleep(2); if (++spins > (1u << 26)) break; }
        }
        __builtin_amdgcn_fence(__ATOMIC_ACQUIRE, "agent");
        asm volatile("s_waitcnt vmcnt(0)" ::: "memory");
    }
    __syncthreads();
}
__global__ void __launch_bounds__(NTHREADS) fwd_megakernel(Args a) {
    extern __shared__ __attribute__((aligned(16))) unsigned char lds_raw[];
    LAS unsigned char* lds = (LAS unsigned char*)lds_raw;
    cg::grid_group grid = cg::this_grid();
#define PHASE_PTRS() int tid = threadIdx.x; asm volatile("" : "+v"(tid)); const int lane = tid & 63, wave = __builtin_amdgcn_readfirstlane(tid >> 6); \
    int bx = blockIdx.x; asm volatile("" : "+s"(bx)); const int G = gridDim.x; \
    const int vcu = (G % 8 == 0) ? (bx % 8) * (G / 8) + bx / 8 : bx; const int gw = vcu * 8 + wave, NGW = G * 8; (void)lane; (void)gw; (void)NGW; (void)vcu; \
    kargs_t ka = (kargs_t)__builtin_amdgcn_kernarg_segment_ptr(); asm volatile("" : "+s"(ka)); \
    unsigned char* ws = ka->ws; float* out = ka->out; const float* x = ka->in[IN_X]; (void)x; (void)out; \
    bf16_t* XN = (bf16_t*)(ws + WS_XN); bf16_t* Y1 = (bf16_t*)(ws + WS_Y1); bf16_t* Zb = (bf16_t*)(ws + WS_Z); bf16_t* Gb = (bf16_t*)out; \
    (void)XN; (void)Y1; (void)Zb; (void)Gb
#ifndef PHASE_MASK
#define PHASE_MASK 0xFFF
#endif
#define IN(k) (((PHASE_MASK >> (k)) & 1) && ph_in(k))
#define SEAM(k) do { if (IN(k) && IN((k) + 1)) { if ((k) == 0) grid.sync(); else grid_bar((unsigned*)a.ws, gridDim.x); } } while (0)

    if (IN(0)) {
        PHASE_PTRS();
        bf16_t* Win_t = (bf16_t*)(ws + WS_WIN); bf16_t* Wpa_t = (bf16_t*)(ws + WS_WPA); bf16_t* Wpb_t = (bf16_t*)(ws + WS_WPB); bf16_t* Wout_t = (bf16_t*)(ws + WS_WOUT);
        bf16_t* Wgu2_t = (bf16_t*)(ws + WS_WGU2); bf16_t* Wd2_t = (bf16_t*)(ws + WS_WD2);
        bf16_t* Wgu1_t = (bf16_t*)((unsigned char*)out + OUT_WGU1); bf16_t* Wd1_t = (bf16_t*)((unsigned char*)out + OUT_WD1);
        float* rope = (float*)(ws + WS_ROPE);
        LAS float* scr = (LAS float*)(lds + wave * 16384);
        constexpr int I_IN = 16 * (NIN / 32), I_SQ = 16 * 32, I_PB = 4 * 32, I_GU = 16 * (NGU / 32), I_DN = (DFF / 64) * 32;
        constexpr int NITEMS = I_IN + 2 * I_SQ + I_PB + 2 * I_GU + 2 * I_DN;
        for (int it = gw; it < NITEMS; it += NGW) {
            int r = it;
            if (r < I_GU) { transpose_item<true>(ka->in[IN_WGU1], DM, NGU, Wgu1_t, scr, r, lane); continue; } r -= I_GU;
            if (r < I_DN) { transpose_item<false>(ka->in[IN_WD1], DFF, DM, Wd1_t, scr, r, lane); continue; } r -= I_DN;
            if (r < I_IN) { transpose_item<false>(ka->in[IN_WIN], DM, NIN, Win_t, scr, r, lane); continue; } r -= I_IN;
            if (r < I_SQ) { transpose_item<false>(ka->in[IN_WPA], DM, DM, Wpa_t, scr, r, lane); continue; } r -= I_SQ;
            if (r < I_PB) { transpose_item<false>(ka->in[IN_WPB], 256, DM, Wpb_t, scr, r, lane); continue; } r -= I_PB;
            if (r < I_SQ) { transpose_item<false>(ka->in[IN_WOUT], DM, DM, Wout_t, scr, r, lane); continue; } r -= I_SQ;
            if (r < I_GU) { transpose_item<true>(ka->in[IN_WGU2], DM, NGU, Wgu2_t, scr, r, lane); continue; } r -= I_GU;
            transpose_item<false>(ka->in[IN_WD2], DFF, DM, Wd2_t, scr, r, lane);
        }
        {
            const int* pos = (const int*)ka->in[IN_POS];
            const float invf[8] = {1.0f, 0.1939227432012558f, 0.03760603070259094f, 0.007292664609849453f, 0.0014142135623842478f, 0.00027424818836152554f, 5.3182957344688475e-05f, 1.0313385246263351e-05f};
            for (int i = bx * NTHREADS + tid; i < MROWS * 8; i += G * NTHREADS) {
                const int row = i >> 3, f = i & 7;
                float fv = invf[0];
#pragma unroll
                for (int q = 1; q < 8; ++q) fv = (f == q) ? invf[q] : fv;
                const float ang = (float)pos[row] * fv; float c, s; sincos_d((double)ang, c, s);
                rope[(size_t)row * 16 + f] = c; rope[(size_t)row * 16 + 8 + f] = s;
            }
        }
        for (int m = gw; m < MROWS; m += NGW) { f32x4 v[4]; ld_f32_row(x + (size_t)m * DM, lane, v); norm_to_bf16(v, ka->in[IN_GPRE1], lane, XN + (size_t)m * DM); }
        if (bx == 0 && tid == 0) { __hip_atomic_store((unsigned*)ws, 0u, __ATOMIC_RELAXED, __HIP_MEMORY_SCOPE_AGENT); __hip_atomic_store((unsigned*)ws + 64, 0u, __ATOMIC_RELAXED, __HIP_MEMORY_SCOPE_AGENT); }
        __syncthreads();
    }
    SEAM(0);
    if (IN(1)) {
        PHASE_PTRS(); bf16_t* Hb = Zb; bf16_t* Wgu1_t = (bf16_t*)((unsigned char*)out + OUT_WGU1);
        pg8::Gemm g{XN, Wgu1_t, MROWS, NGU, DM, DM}; pg8::StaticOrder S; S.init(MROWS, NGU, G, bx);
        pg8::EpiT<pg8::EPI_SWIGLU> E{Hb, DFF, nullptr, nullptr};
        pg8::gemm_phase<pg8::EpiT<pg8::EPI_SWIGLU>, true>(lds, g, S, E);
    }
    SEAM(1);
    if (IN(2)) {
        PHASE_PTRS(); bf16_t* Hb = Zb; bf16_t* Wd1_t = (bf16_t*)((unsigned char*)out + OUT_WD1);
        pg8::Gemm g{Hb, Wd1_t, MROWS, DM, DFF, DFF}; pg8::StaticOrder S; S.init(MROWS, DM, G, bx);
        pg8::EpiT<pg8::EPI_PLAIN> E{Y1, DM, nullptr, nullptr};
        pg8::gemm_phase<pg8::EpiT<pg8::EPI_PLAIN>, true>(lds, g, S, E);
    }
    SEAM(2);
    if (IN(3)) {
        PHASE_PTRS();
        for (int m = gw; m < MROWS; m += NGW) {
            f32x4 xv[4], y[4]; ld_f32_row(x + (size_t)m * DM, lane, xv); ld_bf16_row(Y1 + (size_t)m * DM, lane, y);
            add_normed(xv, y, ka->in[IN_GPOST1], lane, 0.5f);
            norm_to_bf16(xv, ka->in[IN_GPREM], lane, XN + (size_t)m * DM);
        }
    }
    SEAM(3);
    if (IN(4)) {
        PHASE_PTRS(); bf16_t* Win_t = (bf16_t*)(ws + WS_WIN); float* rope = (float*)(ws + WS_ROPE);
        pg8::Gemm g{XN, Win_t, MROWS, NIN, DM, DM}; pg8::StaticOrder S; S.init(MROWS, NIN, G, bx);
        pg8::EpiT<pg8::EPI_WIN> E{Zb, ZP, Gb, rope};
        pg8::gemm_phase<pg8::EpiT<pg8::EPI_WIN>, true>(lds, g, S, E);
    }
    SEAM(4);
    if (IN(5)) {
        PHASE_PTRS();
        float lam;
        { const float d1 = wave_sum(ka->in[IN_LQ1][lane] * ka->in[IN_LK1][lane]), d2 = wave_sum(ka->in[IN_LQ2][lane] * ka->in[IN_LK2][lane]);
          lam = fast_exp2(d1 * LOG2E) - fast_exp2(d2 * LOG2E) + LAMBDA_INIT; }
#ifndef NO_DIL
        for (int u = vcu; u < BATCH * 4 * 32; u += G) { const int bh = u >> 5, qb = u & 31; dil_unit(bh >> 2, bh & 3, qb, Zb, lds); }
#endif
        __syncthreads();
#ifndef NO_DIFF
        for (int u = vcu; u < BATCH * 8 * 32; u += G) { const int bh = u >> 5, qb = u & 31; diff_unit<8>(bh >> 3, bh & 7, qb, Zb, ka->in[IN_GSUB], lam, lds); }
#endif
        __syncthreads();
    }
    SEAM(5);
    if (IN(6)) {
        PHASE_PTRS(); bf16_t* MERGED = XN; bf16_t* Wpa_t = (bf16_t*)(ws + WS_WPA); bf16_t* Wpb_t = (bf16_t*)(ws + WS_WPB);
#ifndef NO_PB
        { int kpb = 256; asm volatile("" : "+s"(kpb));
          pg8::Gemm g{Zb + ZC_QD, Wpb_t, MROWS, DM, kpb, ZP}; pg8::StaticOrder S; S.init(MROWS, DM, G, bx);
          pg8::EpiT<pg8::EPI_PROJB> E{MERGED, DM, Gb, nullptr};
          pg8::gemm_phase<pg8::EpiT<pg8::EPI_PROJB>, true>(lds, g, S, E); }
#endif
#ifndef NO_PA
        { pg8::Gemm g{Zb, Wpa_t, MROWS, DM, DM, ZP}; pg8::StaticOrder S; S.init(MROWS, DM, G, bx);
          pg8::EpiT<pg8::EPI_PROJA> E{MERGED, DM, Gb, nullptr};
          pg8::gemm_phase<pg8::EpiT<pg8::EPI_PROJA>, true>(lds, g, S, E); }
#endif
    }
    SEAM(6);
    if (IN(7)) {
        PHASE_PTRS(); bf16_t* MERGED = XN; bf16_t* Y2 = Zb; bf16_t* Wout_t = (bf16_t*)(ws + WS_WOUT);
        pg8::Gemm g{MERGED, Wout_t, MROWS, DM, DM, DM}; pg8::StaticOrder S; S.init(MROWS, DM, G, bx);
        pg8::EpiT<pg8::EPI_PLAIN> E{Y2, DM, nullptr, nullptr};
        pg8::gemm_phase<pg8::EpiT<pg8::EPI_PLAIN>, true>(lds, g, S, E);
    }
    SEAM(7);
    if (IN(8)) {
        PHASE_PTRS(); bf16_t* Y2 = Zb;
        for (int m = gw; m < MROWS; m += NGW) {
            f32x4 xv[4], y[4]; ld_f32_row(x + (size_t)m * DM, lane, xv); ld_bf16_row(Y1 + (size_t)m * DM, lane, y);
            add_normed(xv, y, ka->in[IN_GPOST1], lane, 0.5f);
            ld_bf16_row(Y2 + (size_t)m * DM, lane, y);
            add_normed(xv, y, ka->in[IN_GPOSTM], lane, 1.0f);
            st_f32_row(out + (size_t)m * DM, lane, xv);
            norm_to_bf16(xv, ka->in[IN_GPRE2], lane, XN + (size_t)m * DM);
        }
    }
    SEAM(8);
    if (IN(9)) {
        PHASE_PTRS(); bf16_t* Hb = Zb; bf16_t* Wgu2_t = (bf16_t*)(ws + WS_WGU2);
        pg8::Gemm g{XN, Wgu2_t, MROWS, NGU, DM, DM}; pg8::StaticOrder S; S.init(MROWS, NGU, G, bx);
        pg8::EpiT<pg8::EPI_SWIGLU> E{Hb, DFF, nullptr, nullptr};
        pg8::gemm_phase<pg8::EpiT<pg8::EPI_SWIGLU>, true>(lds, g, S, E);
    }
    SEAM(9);
    if (IN(10)) {
        PHASE_PTRS(); bf16_t* Hb = Zb; bf16_t* Y3 = Y1; bf16_t* Wd2_t = (bf16_t*)(ws + WS_WD2);
        pg8::Gemm g{Hb, Wd2_t, MROWS, DM, DFF, DFF}; pg8::StaticOrder S; S.init(MROWS, DM, G, bx);
        pg8::EpiT<pg8::EPI_PLAIN> E{Y3, DM, nullptr, nullptr};
        pg8::gemm_phase<pg8::EpiT<pg8::EPI_PLAIN>, true>(lds, g, S, E);
    }
    SEAM(10);
    if (IN(11)) {
        PHASE_PTRS(); bf16_t* Y3 = Y1;
        for (int m = gw; m < MROWS; m += NGW) {
            f32x4 xv[4], y[4]; ld_f32_row(out + (size_t)m * DM, lane, xv); ld_bf16_row(Y3 + (size_t)m * DM, lane, y);
            add_normed(xv, y, ka->in[IN_GPOST2], lane, 0.5f);
            st_f32_row(out + (size_t)m * DM, lane, xv);
        }
    }
#undef IN
#undef SEAM
}

extern "C" void kernel_launch(void* const* d_in, const int* in_sizes, int n_in, void* d_out, int out_size, void* d_ws, size_t ws_size, hipStream_t stream) {
    static int grid = 0;
    if (grid == 0) {
        if (n_in != 21 || out_size != MROWS * DM || ws_size < WS_END) { fprintf(stderr, "kernel_launch: unexpected shapes (n_in %d out %d ws %zu)\n", n_in, out_size, ws_size); grid = -1; return; }
        int dev = 0, cus = 0, per_cu = 0;
        (void)hipGetDevice(&dev); (void)hipDeviceGetAttribute(&cus, hipDeviceAttributeMultiprocessorCount, dev);
        if (hipFuncSetAttribute((const void*)fwd_megakernel, hipFuncAttributeMaxDynamicSharedMemorySize, LDS_BYTES) != hipSuccess) { fprintf(stderr, "kernel_launch: hipFuncSetAttribute failed\n"); grid = -1; return; }
        if (hipOccupancyMaxActiveBlocksPerMultiprocessor(&per_cu, (const void*)fwd_megakernel, NTHREADS, LDS_BYTES) != hipSuccess || per_cu < 1) { fprintf(stderr, "kernel_launch: occupancy query says %d\n", per_cu); per_cu = 1; (void)hipGetLastError(); }
        grid = cus * per_cu;
    }
    if (grid < 0) return;
    Args a{};
    for (int i = 0; i < 21; ++i) a.in[i] = (const float*)d_in[i];
    a.out = (float*)d_out; a.ws = (unsigned char*)d_ws;
#if MK_N_LAUNCHES == 1
    a.ph_lo = 0; a.ph_hi = N_PHASES;
    void* args[] = {&a};
    hipError_t e = hipLaunchCooperativeKernel((const void*)fwd_megakernel, dim3(grid), dim3(NTHREADS), args, LDS_BYTES, stream);
    if (e != hipSuccess) fprintf(stderr, "cooperative launch failed: %s (grid %d)\n", hipGetErrorString(e), grid);
#else
    for (int p = 0; p < N_PHASES; ++p) { a.ph_lo = p; a.ph_hi = p + 1; hipLaunchKernelGGL(fwd_megakernel, dim3(grid), dim3(NTHREADS), LDS_BYTES, stream, a); }
#endif
}
```

```cpp
#include <hip/hip_runtime.h>
#include <hip/hip_cooperative_groups.h>
#include <cstdio>
#include <cstdint>
namespace cg = cooperative_groups;

#ifndef MK_N_LAUNCHES
#define MK_N_LAUNCHES 1
#endif

#define LAS __attribute__((address_space(3)))
typedef unsigned short bf16_t;
typedef short bf16x8 __attribute__((ext_vector_type(8)));
typedef short s16x4 __attribute__((ext_vector_type(4)));
typedef float f32x4 __attribute__((ext_vector_type(4)));
typedef float f32x16 __attribute__((ext_vector_type(16)));
typedef unsigned u32x4 __attribute__((ext_vector_type(4)));
typedef unsigned u32x2 __attribute__((ext_vector_type(2)));
typedef float f32x2_t __attribute__((ext_vector_type(2)));
typedef __bf16 bf16x2_t __attribute__((ext_vector_type(2)));

constexpr int BATCH = 4, SEQ = 8192, DM = 1024, MROWS = BATCH * SEQ, DFF = 2816, NGU = 2 * DFF, NIN = 7424;
constexpr int ZP = 5376;
constexpr int GP = 2048;
constexpr int ZC_KA = 1024, ZC_VA = 2048, ZC_QD = 3072, ZC_KD = 3840, ZC_VD = 4608;
constexpr float EPS = 1e-6f;
constexpr float LOG2E = 1.4426950408889634f;
constexpr float C2 = 0.125f * LOG2E;
constexpr float LAMBDA_INIT = 0.2f;

constexpr size_t MiB = 1u << 20;
constexpr size_t WS_ROPE = 1 * MiB;
constexpr size_t WS_WIN = 4 * MiB;
constexpr size_t WS_WPA = 19 * MiB;
constexpr size_t WS_WPB = 21 * MiB;
constexpr size_t WS_WOUT = 22 * MiB;
constexpr size_t WS_WGU2 = 24 * MiB;
constexpr size_t WS_WD2 = 35 * MiB;
constexpr size_t WS_XN = 41 * MiB;
constexpr size_t WS_Y1 = 105 * MiB;
constexpr size_t WS_Z = 169 * MiB;
constexpr size_t WS_END = 505 * MiB;
constexpr size_t OUT_WGU1 = 0, OUT_WD1 = 11 * MiB;

constexpr int LDS_BYTES = 139264;
constexpr int NTHREADS = 512;

__device__ __forceinline__ unsigned cvtpk(float lo, float hi) { f32x2_t v = {lo, hi}; bf16x2_t b = __builtin_convertvector(v, bf16x2_t); return __builtin_bit_cast(unsigned, b); }
__device__ __forceinline__ float bflo(unsigned w) { return __uint_as_float(w << 16); }
__device__ __forceinline__ float bfhi(unsigned w) { return __uint_as_float(w & 0xffff0000u); }
__device__ __forceinline__ float fast_rcp(float x) { return __builtin_amdgcn_rcpf(x); }
__device__ __forceinline__ float fast_exp2(float x) { return __builtin_amdgcn_exp2f(x); }
__device__ __forceinline__ float sigmoidf_(float x) { return fast_rcp(1.f + fast_exp2(-x * LOG2E)); }
__device__ __forceinline__ float wave_sum(float v) {
#pragma unroll
    for (int o = 1; o < 64; o <<= 1) v += __shfl_xor(v, o);
    return v;
}

namespace pg8 {
constexpr int BM = 256, BK = 64, HALF = 128, HTB = HALF * BK * 2, STAGE_BYTES = 8 * HTB, NXCD = 8, WGM = 4;
__host__ __device__ __forceinline__ int lds_byte(int r, int c) { const int st = (r >> 4) * 2 + (c >> 5), rr = r & 15, cc = c & 31, ob = rr * 64 + cc * 2; return st * 1024 + (ob ^ (((ob >> 9) & 1) << 5)); }
__host__ __device__ __forceinline__ void stage_rc(int b, int& R, int& C) { const int st = b / 1024, sb = b % 1024, swz = sb ^ (((sb >> 9) & 1) << 5); R = (st >> 1) * 16 + swz / 64; C = (st & 1) * 32 + (swz % 64) / 2; }
__host__ __device__ __forceinline__ int perm32(int rho) { const int n = rho >> 4, i = rho & 15; return 8 * (i >> 2) + 4 * n + (i & 3); }

struct Unit { int pm, pn; };
struct Gemm { const bf16_t* A; const bf16_t* Bt; int M, N, K, lda; };

struct StaticOrder {
    int nM, nN, nwg, G, c;
    __device__ void init(int M, int N, int G_, int c_) { nM = M / BM; nN = N / BM; nwg = nM * nN; G = G_; c = c_; }
    __device__ bool next(int i, Unit& u) const {
        const long L = (long)i * G + c; if (L >= nwg) return false;
        int wgid = (int)L; { const int q = nwg / NXCD, r = nwg % NXCD, xcd = wgid % NXCD, off = wgid / NXCD; wgid = (xcd < r ? xcd * (q + 1) : r * (q + 1) + (xcd - r) * q) + off; }
        const int nig = WGM * nN, gid = wgid / nig, fm = gid * WGM, gsz = (nM - fm) < WGM ? (nM - fm) : WGM;
        u.pm = fm + ((wgid % nig) % gsz); u.pn = (wgid % nig) / gsz; return true;
    }
};

enum { EPI_PLAIN = 0, EPI_SWIGLU = 1, EPI_WIN = 2, EPI_PROJB = 3, EPI_PROJA = 4 };
template <int MODE> struct EpiT {
    static constexpr bool PERM = true;
    bf16_t* O; int ldc;
    bf16_t* G;
    const float* rope;
    __device__ __forceinline__ void operator()(const f32x4 (&acc)[2][2][4][2], const Unit& u, int wr, int wc, int fr, int fq) const {
        const int row0 = u.pm * BM + wr * 64 + fr;
        if constexpr (MODE == EPI_PLAIN) {
            const int col0 = u.pn * BM + wc * 32 + 8 * fq;
#pragma unroll
            for (int ai = 0; ai < 2; ++ai)
#pragma unroll
                for (int m = 0; m < 4; ++m) { bf16_t* rowp = O + (size_t)(row0 + ai * HALF + m * 16) * ldc + col0;
#pragma unroll
                    for (int bj = 0; bj < 2; ++bj) { const f32x4 v0 = acc[ai][bj][m][0], v1 = acc[ai][bj][m][1];
                        u32x4 w; w.x = cvtpk(v0[0], v0[1]); w.y = cvtpk(v0[2], v0[3]); w.z = cvtpk(v1[0], v1[1]); w.w = cvtpk(v1[2], v1[3]);
                        *(u32x4*)(rowp + bj * HALF) = w; } }
        } else if constexpr (MODE == EPI_SWIGLU) {
            const int col0 = u.pn * HALF + wc * 32 + 8 * fq;
#pragma unroll
            for (int ai = 0; ai < 2; ++ai)
#pragma unroll
                for (int m = 0; m < 4; ++m) { bf16_t* rowp = O + (size_t)(row0 + ai * HALF + m * 16) * ldc + col0;
                    float h[8];
#pragma unroll
                    for (int n = 0; n < 2; ++n)
#pragma unroll
                        for (int e = 0; e < 4; ++e) { const float g = acc[ai][0][m][n][e], uu = acc[ai][1][m][n][e]; h[4 * n + e] = g * sigmoidf_(g) * uu; }
                    u32x4 w; w.x = cvtpk(h[0], h[1]); w.y = cvtpk(h[2], h[3]); w.z = cvtpk(h[4], h[5]); w.w = cvtpk(h[6], h[7]);
                    *(u32x4*)rowp = w; }
        } else if constexpr (MODE == EPI_WIN) {
            const int pn = u.pn;
            if (pn >= 21) {
                const int col0 = (pn - 21) * BM + wc * 32 + 8 * fq;
#pragma unroll
                for (int ai = 0; ai < 2; ++ai)
#pragma unroll
                    for (int m = 0; m < 4; ++m) { bf16_t* rowp = G + (size_t)(row0 + ai * HALF + m * 16) * GP + col0;
#pragma unroll
                        for (int bj = 0; bj < 2; ++bj) { const f32x4 v0 = acc[ai][bj][m][0], v1 = acc[ai][bj][m][1];
                            u32x4 w; w.x = cvtpk(sigmoidf_(v0[0]), sigmoidf_(v0[1])); w.y = cvtpk(sigmoidf_(v0[2]), sigmoidf_(v0[3]));
                            w.z = cvtpk(sigmoidf_(v1[0]), sigmoidf_(v1[1])); w.w = cvtpk(sigmoidf_(v1[2]), sigmoidf_(v1[3]));
                            *(u32x4*)(rowp + bj * HALF) = w; } }
            } else {
                const bool isq = (pn < 4) || (pn >= 12 && pn < 15);
                const bool isrope = (pn < 8) || (pn >= 12 && pn < 18);
                const float sc = isq ? C2 : 1.f;
                const int col0 = pn * BM + wc * 32 + 8 * fq;
                const bool dorope = isrope && ((wc & 1) == 0);
                const float sgn = (fq == 0) ? -1.f : 1.f;
#pragma unroll
                for (int ai = 0; ai < 2; ++ai)
#pragma unroll
                    for (int m = 0; m < 4; ++m) { const int row = row0 + ai * HALF + m * 16; bf16_t* rowp = O + (size_t)row * ZP + col0;
                        f32x4 cs0 = {1.f, 1.f, 1.f, 1.f}, cs1 = cs0, sn0 = {0.f, 0.f, 0.f, 0.f}, sn1 = sn0;
                        if (dorope) { const f32x4* rp = (const f32x4*)(rope + (size_t)row * 16); cs0 = rp[0]; cs1 = rp[1]; sn0 = rp[2]; sn1 = rp[3]; }
#pragma unroll
                        for (int bj = 0; bj < 2; ++bj) { f32x4 v0 = acc[ai][bj][m][0], v1 = acc[ai][bj][m][1];
                            if (dorope) {
                                f32x4 o0, o1;
#pragma unroll
                                for (int e = 0; e < 4; ++e) { o0[e] = __shfl_xor(v0[e], 16); o1[e] = __shfl_xor(v1[e], 16); }
                                if (fq < 2) { v0 = v0 * cs0 + sgn * o0 * sn0; v1 = v1 * cs1 + sgn * o1 * sn1; }
                            }
                            v0 = v0 * sc; v1 = v1 * sc;
                            u32x4 w; w.x = cvtpk(v0[0], v0[1]); w.y = cvtpk(v0[2], v0[3]); w.z = cvtpk(v1[0], v1[1]); w.w = cvtpk(v1[2], v1[3]);
                            *(u32x4*)(rowp + bj * HALF) = w; } }
            }
        } else {
            const int col0 = u.pn * BM + wc * 32 + 8 * fq;
            const int gcol0 = (MODE == EPI_PROJB ? 1024 : 0) + col0;
#pragma unroll
            for (int ai = 0; ai < 2; ++ai)
#pragma unroll
                for (int m = 0; m < 4; ++m) { const int row = row0 + ai * HALF + m * 16; bf16_t* rowp = O + (size_t)row * ldc + col0; const bf16_t* gp = G + (size_t)row * GP + gcol0;
#pragma unroll
                    for (int bj = 0; bj < 2; ++bj) { const f32x4 v0 = acc[ai][bj][m][0], v1 = acc[ai][bj][m][1];
                        const u32x4 gw = *(const u32x4*)(gp + bj * HALF);
                        float r[8];
                        r[0] = bflo(gw.x) * v0[0]; r[1] = bfhi(gw.x) * v0[1]; r[2] = bflo(gw.y) * v0[2]; r[3] = bfhi(gw.y) * v0[3];
                        r[4] = bflo(gw.z) * v1[0]; r[5] = bfhi(gw.z) * v1[1]; r[6] = bflo(gw.w) * v1[2]; r[7] = bfhi(gw.w) * v1[3];
                        if constexpr (MODE == EPI_PROJA) { const u32x4 pw = *(const u32x4*)(rowp + bj * HALF);
                            r[0] += bflo(pw.x); r[1] += bfhi(pw.x); r[2] += bflo(pw.y); r[3] += bfhi(pw.y); r[4] += bflo(pw.z); r[5] += bfhi(pw.z); r[6] += bflo(pw.w); r[7] += bfhi(pw.w); }
                        u32x4 w; w.x = cvtpk(r[0], r[1]); w.y = cvtpk(r[2], r[3]); w.z = cvtpk(r[4], r[5]); w.w = cvtpk(r[6], r[7]);
                        *(u32x4*)(rowp + bj * HALF) = w; }
                    asm volatile("" ::: "memory"); }
        }
    }
};

template <class Epi, bool ALIGN_EPI>
__device__ __forceinline__ void gemm_phase(LAS unsigned char* lds, const Gemm g, const StaticOrder& S, const Epi& E) {
    const int tid = threadIdx.x, wid = __builtin_amdgcn_readfirstlane(tid >> 6), lane = tid & 63, wr = wid >> 2, wc = wid & 3, fr = lane & 15, fq = lane >> 4;
    const int K = g.K, nt = K / BK, lda = g.lda;
    unsigned voffA[2], voffB[2];
#pragma unroll
    for (int i = 0; i < 2; ++i) { int R, C; stage_rc(tid * 16 + i * 8192, R, C); const int Rb = Epi::PERM ? ((R & ~31) + perm32(R & 31)) : R;
        voffA[i] = (unsigned)(R * lda + C) * 2u; voffB[i] = (unsigned)(Rb * K + C) * 2u; }
    const size_t kstep = (size_t)(BK * 2);
    const size_t hstepA = (size_t)HALF * lda * 2, hstepB = (size_t)HALF * K * 2;
    const size_t tstepA = 2 * hstepA, tstepB = 2 * hstepB;
    const unsigned ldsw = (unsigned)wid * 1024u;
    const int aoff = lds_byte(wr * 64 + fr, fq * 8), boff = lds_byte(wc * 32 + fr, fq * 8);
#define PG8_SA(b, h) (((b) * 2 + (h)) * HTB)
#define PG8_SB(b, h) ((4 + (b) * 2 + (h)) * HTB)
#define PG8_STAGE(bufoff, gbase, voff) do { _Pragma("unroll") for (int _i = 0; _i < 2; ++_i) \
        __builtin_amdgcn_global_load_lds((const unsigned*)((const char*)(gbase) + (voff)[_i]), (LAS unsigned*)(lds + (bufoff) + ldsw + _i * 8192), 16, 0, 0); } while (0)
#define PG8_LDA(dst, b, h) do { _Pragma("unroll") for (int m = 0; m < 4; ++m) _Pragma("unroll") for (int k = 0; k < 2; ++k) dst[m][k] = *(const LAS bf16x8*)(lds + PG8_SA(b, h) + aoff + m * 2048 + k * 1024); } while (0)
#define PG8_LDB(dst, b, h) do { _Pragma("unroll") for (int n = 0; n < 2; ++n) _Pragma("unroll") for (int k = 0; k < 2; ++k) dst[n][k] = *(const LAS bf16x8*)(lds + PG8_SB(b, h) + boff + n * 2048 + k * 1024); } while (0)
#define PG8_MMA(ai, bj, At, Bt) do { __builtin_amdgcn_s_setprio(1); _Pragma("unroll") for (int m = 0; m < 4; ++m) _Pragma("unroll") for (int n = 0; n < 2; ++n) _Pragma("unroll") for (int k = 0; k < 2; ++k) \
        acc[ai][bj][m][n] = __builtin_amdgcn_mfma_f32_16x16x32_bf16(Bt[n][k], At[m][k], acc[ai][bj][m][n], 0, 0, 0); __builtin_amdgcn_s_setprio(0); } while (0)
#define PG8_WAIT_V(n) asm volatile("s_waitcnt vmcnt(" #n ")" ::: "memory")
#define PG8_WAIT_L(n) asm volatile("s_waitcnt lgkmcnt(" #n ")" ::: "memory")
#define PG8_BAR __builtin_amdgcn_s_barrier()
#define PG8_SCHED __builtin_amdgcn_sched_barrier(0)
    Unit cur, nxt; int ui = 0;
    if (!S.next(0, cur)) return;
    f32x4 acc[2][2][4][2];
#pragma unroll
    for (int a = 0; a < 2; ++a)
#pragma unroll
        for (int b = 0; b < 2; ++b)
#pragma unroll
            for (int m = 0; m < 4; ++m)
#pragma unroll
                for (int n = 0; n < 2; ++n) acc[a][b][m][n] = (f32x4){0.f, 0.f, 0.f, 0.f};
    bf16x8 At[4][2], B0[2][2], B1[2][2];
    const char* cA = (const char*)g.A + (size_t)cur.pm * tstepA; const char* cB = (const char*)g.Bt + (size_t)cur.pn * tstepB;
    PG8_STAGE(PG8_SB(0, 0), cB, voffB); PG8_STAGE(PG8_SB(0, 1), cB + hstepB, voffB); PG8_STAGE(PG8_SA(0, 0), cA, voffA); PG8_STAGE(PG8_SA(0, 1), cA + hstepA, voffA);
    if (wr == 1) PG8_BAR;
    PG8_WAIT_V(2); PG8_BAR;
    PG8_STAGE(PG8_SB(1, 0), cB + kstep, voffB); PG8_STAGE(PG8_SA(1, 0), cA + kstep, voffA); PG8_STAGE(PG8_SB(1, 1), cB + hstepB + kstep, voffB);
    PG8_WAIT_V(6); PG8_BAR;
    for (;;) {
        const bool has_next = S.next(ui + 1, nxt);
        const char* nA = has_next ? (const char*)g.A + (size_t)nxt.pm * tstepA : cA; const char* nB = has_next ? (const char*)g.Bt + (size_t)nxt.pn * tstepB : cB;
        for (int t = 0; t < nt; t += 2) {
            const bool last = (t == nt - 2);
            const char* a1 = cA + (size_t)(t + 1) * kstep;
            const char* a2 = last ? nA : cA + (size_t)(t + 2) * kstep; const char* b2 = last ? nB : cB + (size_t)(t + 2) * kstep;
            const char* a3 = a2 + kstep; const char* b3 = b2 + kstep;
            PG8_LDB(B0, 0, 0); PG8_LDB(B1, 0, 1); PG8_SCHED; PG8_LDA(At, 0, 0); PG8_STAGE(PG8_SA(1, 1), a1 + hstepA, voffA);
            PG8_WAIT_V(8); PG8_WAIT_L(0); PG8_BAR; PG8_MMA(0, 0, At, B0); PG8_MMA(0, 1, At, B1); PG8_BAR; PG8_SCHED;
            PG8_LDA(At, 0, 1); PG8_STAGE(PG8_SB(0, 0), b2, voffB); PG8_STAGE(PG8_SB(0, 1), b2 + hstepB, voffB); PG8_STAGE(PG8_SA(0, 0), a2, voffA);
            PG8_WAIT_V(8); PG8_WAIT_L(0); PG8_BAR; PG8_MMA(1, 0, At, B0); PG8_MMA(1, 1, At, B1); PG8_BAR; PG8_SCHED;
            PG8_LDB(B0, 1, 0); PG8_LDB(B1, 1, 1); PG8_SCHED; PG8_LDA(At, 1, 0); PG8_STAGE(PG8_SA(0, 1), a2 + hstepA, voffA);
            PG8_WAIT_V(8); PG8_WAIT_L(0); PG8_BAR; PG8_MMA(0, 0, At, B0); PG8_MMA(0, 1, At, B1); PG8_BAR; PG8_SCHED;
            PG8_LDA(At, 1, 1); PG8_STAGE(PG8_SB(1, 0), b3, voffB); PG8_STAGE(PG8_SB(1, 1), b3 + hstepB, voffB); PG8_STAGE(PG8_SA(1, 0), a3, voffA);
            PG8_WAIT_V(8); PG8_WAIT_L(0); PG8_BAR; PG8_MMA(1, 0, At, B0); PG8_MMA(1, 1, At, B1); PG8_BAR; PG8_SCHED;
        }
        if constexpr (ALIGN_EPI) { if (wr == 0) PG8_BAR; }
        E(acc, cur, wr, wc, fr, fq);
        if (!has_next) break;
#pragma unroll
        for (int a = 0; a < 2; ++a)
#pragma unroll
            for (int b = 0; b < 2; ++b)
#pragma unroll
                for (int m = 0; m < 4; ++m)
#pragma unroll
                    for (int n = 0; n < 2; ++n) acc[a][b][m][n] = (f32x4){0.f, 0.f, 0.f, 0.f};
        cur = nxt; cA = nA; cB = nB; ++ui;
        if constexpr (ALIGN_EPI) { if (wr == 1) PG8_BAR; }
    }
    PG8_WAIT_V(0);
    if constexpr (!ALIGN_EPI) { if (wr == 0) PG8_BAR; }
    PG8_BAR;
#undef PG8_SA
#undef PG8_SB
#undef PG8_STAGE
#undef PG8_LDA
#undef PG8_LDB
#undef PG8_MMA
#undef PG8_WAIT_V
#undef PG8_WAIT_L
#undef PG8_BAR
#undef PG8_SCHED
}
}

struct Args { const float* in[21]; float* out; unsigned char* ws; int ph_lo, ph_hi; };
enum { IN_X = 0, IN_POS, IN_WIN, IN_LQ1, IN_LK1, IN_LQ2, IN_LK2, IN_GSUB, IN_WPA, IN_WPB, IN_WOUT, IN_WGU1, IN_WD1, IN_WGU2, IN_WD2, IN_GPRE1, IN_GPOST1, IN_GPREM, IN_GPOSTM, IN_GPRE2, IN_GPOST2 };
typedef const __attribute__((address_space(4))) Args* kargs_t;
__device__ __forceinline__ constexpr int crow(int r, int hi) { return (r & 3) + 8 * (r >> 2) + 4 * hi; }
__device__ __forceinline__ s16x4 vtr(const LAS unsigned char* p) {
    typedef short v4i16_t __attribute__((ext_vector_type(4)));
    return __builtin_bit_cast(s16x4, __builtin_amdgcn_ds_read_tr16_b64_v4i16((LAS v4i16_t*)p));
}
__device__ __forceinline__ float max3f(float a, float b, float c) { float r; asm("v_max3_f32 %0, %1, %2, %3" : "=v"(r) : "v"(a), "v"(b), "v"(c)); return r; }
__device__ __forceinline__ float max2f(float a, float b) { float r; asm("v_max_f32_e32 %0, %1, %2" : "=v"(r) : "v"(a), "v"(b)); return r; }
__device__ __forceinline__ float rowmax32(const f32x16& p0, const f32x16& p1) {
    float a = max3f(p0[0], p0[1], p1[0]), b = max3f(p0[2], p0[3], p1[1]); a = max3f(a, p1[2], p1[3]);
#pragma unroll
    for (int r = 4; r < 16; r += 4) { a = max3f(a, p0[r], p0[r + 1]); b = max3f(b, p0[r + 2], p0[r + 3]); a = max3f(a, p1[r], p1[r + 1]); b = max3f(b, p1[r + 2], p1[r + 3]); }
    a = max2f(a, b);
    auto rr = __builtin_amdgcn_permlane32_swap(__float_as_uint(a), __float_as_uint(a), false, false);
    return max2f(__uint_as_float(rr[0]), __uint_as_float(rr[1]));
}
__device__ __forceinline__ float halfmax(float a) {
    auto rr = __builtin_amdgcn_permlane32_swap(__float_as_uint(a), __float_as_uint(a), false, false);
    return max2f(__uint_as_float(rr[0]), __uint_as_float(rr[1]));
}
__device__ __forceinline__ float halfsum(float x) {
    auto rr = __builtin_amdgcn_permlane32_swap(__float_as_uint(x), __float_as_uint(x), false, false);
    return __uint_as_float(rr[0]) + __uint_as_float(rr[1]);
}
#define GLDS16(gsrc, ldsdst) __builtin_amdgcn_global_load_lds((const unsigned*)(gsrc), (LAS unsigned*)(ldsdst), 16, 0, 0)
__device__ __forceinline__ void glds16_asm(const void* gsrc, unsigned lds_dst) {
    unsigned keep;
    asm volatile("s_mov_b32 %0, m0\n\ts_mov_b32 m0, %2\n\ts_nop 0\n\tglobal_load_lds_dwordx4 %1, off\n\ts_mov_b32 m0, %0" : "=&s"(keep) : "v"(gsrc), "s"(lds_dst) : "memory");
}
#define GLDS16A(gsrc, ldsdst) glds16_asm((const void*)(gsrc), (unsigned)__builtin_amdgcn_readfirstlane((int)(unsigned)(uintptr_t)(ldsdst)))
#define WAIT_VM0_BAR() do { asm volatile("s_waitcnt vmcnt(0)" ::: "memory"); __builtin_amdgcn_s_barrier(); asm volatile("" ::: "memory"); } while (0)

template <int THR>
__device__ __forceinline__ bool softmax_tile(f32x16& p0, f32x16& p1, float& m_run, float& l_run, LAS float* wsf, int r32, int hi) {
    const float rm = rowmax32(p0, p1);
    const bool resc = __any(rm > m_run + (float)THR);
    if (resc) {
        const float mn = max2f(m_run, rm); const float f = fast_exp2(m_run - mn); m_run = mn; l_run *= f;
        if (hi == 0) wsf[r32] = f;
    }
    const float mm = m_run; float s = 0.f;
#pragma unroll
    for (int r = 0; r < 16; ++r) { p0[r] = fast_exp2(p0[r] - mm); p1[r] = fast_exp2(p1[r] - mm); s += p0[r] + p1[r]; }
    l_run += s;
    return resc;
}
template <int THR>
__device__ __forceinline__ bool softmax_rel(f32x16& p0, f32x16& p1, float& m_run, float& l_run, bool first, LAS float* wsf, int r32, int hi) {
    const float rm = rowmax32(p0, p1);
    const bool resc = first || __any(rm > (float)THR);
    if (resc) {
        const float dl = first ? rm : fmaxf(rm, 0.f); m_run += dl;
        const float f = first ? 0.f : fast_exp2(-dl); l_run *= f;
        if (hi == 0) wsf[r32] = f;
#pragma unroll
        for (int r = 0; r < 16; ++r) { p0[r] -= dl; p1[r] -= dl; }
    }
    float s = 0.f;
#pragma unroll
    for (int r = 0; r < 16; ++r) { p0[r] = fast_exp2(p0[r]); p1[r] = fast_exp2(p1[r]); s += p0[r] + p1[r]; }
    l_run += s;
    return resc;
}
__device__ __forceinline__ bf16x8 pack8(const f32x16& p, int b) {
    u32x4 w; w.x = cvtpk(p[b], p[b + 1]); w.y = cvtpk(p[b + 2], p[b + 3]); w.z = cvtpk(p[b + 4], p[b + 5]); w.w = cvtpk(p[b + 6], p[b + 7]);
    return __builtin_bit_cast(bf16x8, w);
}
#define MFMA32(a, b, c) __builtin_amdgcn_mfma_f32_32x32x16_bf16((a), (b), (c), 0, 0, 0)

template <int THR>
__device__ __forceinline__ void diff_unit(int b, int h, int qb, bf16_t* Z, const float* gsub, float lam, LAS unsigned char* lds) {
    const int tid = threadIdx.x; int lane_ = tid & 63; asm volatile("" : "+v"(lane_));
    const int lane = lane_, r32 = lane & 31, hi = lane >> 5;
    const int w = __builtin_amdgcn_readfirstlane(tid >> 6);
    const size_t rowbase = (size_t)b * SEQ;
    const int q0 = qb * 256 + w * 32;
    LAS unsigned char* Qw = lds + 67584 + w * 8704;
    { const bf16_t* qg = Z + (rowbase + q0) * ZP + h * 128;
      int l0 = threadIdx.x & 63; asm volatile("" : "+v"(l0));
      const unsigned goff = (unsigned)((l0 >> 4) * ZP + (l0 & 15) * 8), loff = (unsigned)((l0 >> 4) * 272 + (l0 & 15) * 16);
      const bf16_t* qgl = qg + goff; LAS unsigned char* qwl = Qw + loff;
#pragma unroll 1
      for (int j = 0; j < 8; ++j) { *(LAS u32x4*)qwl = *(const u32x4*)qgl; qgl += 4 * ZP; qwl += 4 * 272; } }
    const LAS unsigned char* qrd = Qw + r32 * 272 + hi * 16;
    const int krow = 8 * w + (lane >> 3);
    const bf16_t* kbase = Z + rowbase * ZP + ZC_KA + h * 128;
    const bf16_t* vbase = Z + rowbase * ZP + ZC_VA + h * 128;
    const unsigned koff = (unsigned)(krow * ZP + (((lane & 7) ^ ((krow >> 1) & 7)) << 3));
    const unsigned voff = (unsigned)((4 * w + (lane >> 4)) * ZP + (((lane & 15) ^ (((lane >> 4) & 3) << 2)) << 3));
    const unsigned wl = (unsigned)w * 1024u;
#define DIFF_ISSUE(t, buf) do { const bf16_t* _k = kbase + (size_t)(t) * 64 * ZP; const bf16_t* _v = vbase + (size_t)(t) * 64 * ZP; LAS unsigned char* _b = lds + (buf) * 32768; \
        GLDS16(_k + koff, _b + wl); GLDS16(_k + 64 + koff, _b + 8192 + wl); GLDS16(_v + voff, _b + 16384 + wl); GLDS16(_v + (size_t)32 * ZP + voff, _b + 16384 + 8192 + wl); } while (0)
    const int swz = (r32 >> 1) & 7;
    int kaddr[4];
#pragma unroll
    for (int d0 = 0; d0 < 4; ++d0) kaddr[d0] = r32 * 128 + (((2 * d0 + hi) ^ swz) << 4);
    const int q4 = (lane >> 2) & 3, gb = (lane >> 4) & 1, p4 = lane & 3;
    int vaddr[4];
#pragma unroll
    for (int d = 0; d < 4; ++d) vaddr[d] = (4 * hi + q4) * 256 + ((d ^ q4) << 6) + 32 * gb + 8 * p4;
    LAS float* wsf = (LAS float*)(lds + 65536) + w * 64;

    float m_init = 0.f; asm volatile("" : "+v"(m_init));
    float m_run[2] = {m_init, m_init}, l_run[2] = {0.f, 0.f};
    f32x16 o[2][4];
#pragma unroll
    for (int c = 0; c < 2; ++c)
#pragma unroll
        for (int d = 0; d < 4; ++d)
#pragma unroll
            for (int r = 0; r < 16; ++r) o[c][d][r] = 0.f;
    constexpr int NT = SEQ / 64;
    DIFF_ISSUE(0, 0);
    if (w < 4) __builtin_amdgcn_s_setprio(1);
    for (int t = 0; t < NT; ++t) {
        WAIT_VM0_BAR();
        if (t + 1 < NT) DIFF_ISSUE(t + 1, (t + 1) & 1);
        const LAS unsigned char* B = lds + (t & 1) * 32768;
        bf16x8 pa[2][4]; bool resc[2];
        {
            f32x16 pp[2][2];
#pragma unroll
            for (int d0 = 0; d0 < 4; ++d0) {
#pragma unroll
                for (int c = 0; c < 2; ++c) {
                    const bf16x8 k0 = *(const LAS bf16x8*)(B + c * 8192 + kaddr[d0]);
                    const bf16x8 k1 = *(const LAS bf16x8*)(B + c * 8192 + 4096 + kaddr[d0]);
                    const bf16x8 qv = *(const LAS bf16x8*)(qrd + c * 128 + d0 * 32);
                    if (d0 == 0) { f32x16 negm; const float nm = -m_run[c];
#pragma unroll
                        for (int r = 0; r < 16; ++r) negm[r] = nm;
                        pp[c][0] = MFMA32(k0, qv, negm); pp[c][1] = MFMA32(k1, qv, negm); }
                    else { pp[c][0] = MFMA32(k0, qv, pp[c][0]); pp[c][1] = MFMA32(k1, qv, pp[c][1]); }
                }
                asm volatile("" ::: "memory");
            }
#pragma unroll
            for (int c = 0; c < 2; ++c) {
                resc[c] = softmax_rel<THR>(pp[c][0], pp[c][1], m_run[c], l_run[c], t == 0, wsf + c * 32, r32, hi);
                pa[c][0] = pack8(pp[c][0], 0); pa[c][1] = pack8(pp[c][0], 8); pa[c][2] = pack8(pp[c][1], 0); pa[c][3] = pack8(pp[c][1], 8);
            }
        }
#pragma unroll
        for (int c = 0; c < 2; ++c)
            if (resc[c]) {
#pragma unroll
                for (int r = 0; r < 16; ++r) { const float f = wsf[c * 32 + crow(r, hi)];
#pragma unroll
                    for (int d = 0; d < 4; ++d) o[c][d][r] *= f; }
            }
#pragma unroll
        for (int s = 0; s < 4; ++s)
#pragma unroll
            for (int d = 0; d < 4; ++d) {
                const s16x4 lo = vtr(B + 16384 + vaddr[d] + s * 4096), hi4 = vtr(B + 16384 + vaddr[d] + s * 4096 + 2048);
                const bf16x8 vf = (bf16x8){lo[0], lo[1], lo[2], lo[3], hi4[0], hi4[1], hi4[2], hi4[3]};
                o[0][d] = MFMA32(pa[0][s], vf, o[0][d]); o[1][d] = MFMA32(pa[1][s], vf, o[1][d]);
                if (d & 1) asm volatile("" ::: "memory");
            }
    }
#undef DIFF_ISSUE
    __builtin_amdgcn_s_setprio(0);
    { const float l0 = halfsum(l_run[0]), l1 = halfsum(l_run[1]);
      if (hi == 0) { wsf[r32] = fast_rcp(l0); wsf[32 + r32] = lam * fast_rcp(l1); } }
    int le = threadIdx.x & 63; asm volatile("" : "+v"(le));
    const int r32e = le & 31, hie = le >> 5;
    const LAS float* wse = (const LAS float*)(lds + 65536) + w * 64 + 4 * hie;
    float gs[4];
#pragma unroll
    for (int d = 0; d < 4; ++d) gs[d] = gsub[d * 32 + r32e] * (1.f - LAMBDA_INIT);
    bf16_t* op = Z + (rowbase + q0) * ZP + h * 128;
    const unsigned ooff = (unsigned)(4 * hie * ZP + r32e);
#pragma unroll
    for (int r = 0; r < 16; ++r) {
        const int qc = (r & 3) + 8 * (r >> 2); const float i1 = wse[qc], i2 = wse[32 + qc];
        float v[4]; float ss = 0.f;
#pragma unroll
        for (int d = 0; d < 4; ++d) { v[d] = o[0][d][r] * i1 - o[1][d][r] * i2; ss += v[d] * v[d]; }
        ss += __shfl_xor(ss, 1); ss += __shfl_xor(ss, 2); ss += __shfl_xor(ss, 4); ss += __shfl_xor(ss, 8); ss += __shfl_xor(ss, 16);
        const float rstd = 1.0f / sqrtf(ss * (1.f / 128.f) + EPS);
#pragma unroll
        for (int d = 0; d < 4; ++d) { const unsigned pk = cvtpk(v[d] * rstd * gs[d], 0.f); op[ooff + (unsigned)(qc * ZP + d * 32)] = (bf16_t)(pk & 0xffffu); }
    }
}

template <int DIL>
__device__ __forceinline__ void dil_group(int g, size_t rowbase, int hg, int qb, const bf16_t* Z, LAS unsigned char* lds, float& m_run, float& l_run, f32x16 (&o)[2],
                                          int lane, int r32, int hi, int w, LAS float* wsf) {
    const int head = 4 * g + hg;
    const int blk = qb * 256, tq = blk + 16 * (r32 >> 1) + 2 * w + (r32 & 1);
    bf16x8 qf[4];
    { const bf16_t* qp = Z + (rowbase + tq) * ZP + ZC_QD + head * 64 + hi * 8;
#pragma unroll
      for (int d0 = 0; d0 < 4; ++d0) qf[d0] = *(const bf16x8*)(qp + d0 * 16); }
    f32x16 am;
#pragma unroll
    for (int r = 0; r < 16; ++r) am[r] = ((((r & 3) + 8 * (r >> 2) + 4 * hi - tq) & (DIL - 1)) == 0) ? 0.f : -INFINITY;
    int kstart = qb * 256 - 64 * DIL; if (kstart < 0) kstart = 0;
    int kend = qb * 256 + 256 + 64 * DIL; if (kend > SEQ) kend = SEQ;
    const int NT = (kend - kstart) >> 6;
    const int krow = 8 * w + (lane >> 3);
    const bf16_t* ksrc = Z + (rowbase + kstart + krow) * ZP + ZC_KD + head * 64 + (((lane & 7) ^ ((krow >> 1) & 7)) << 3);
    const bf16_t* vsrc = Z + (rowbase + kstart + krow) * ZP + ZC_VD + head * 64 + (((lane & 7) ^ (((krow >> 1) & 1) << 2)) << 3);
    const unsigned wl = (unsigned)w * 1024u;
#define DIL_ISSUE(t, buf) do { const size_t _o = (size_t)(t) * 64 * ZP; LAS unsigned char* _b = lds + (buf) * 16384; GLDS16(ksrc + _o, _b + wl); GLDS16(vsrc + _o, _b + 8192 + wl); } while (0)
    const int swz = (r32 >> 1) & 7;
    int kaddr[4];
#pragma unroll
    for (int d0 = 0; d0 < 4; ++d0) kaddr[d0] = r32 * 128 + (((2 * d0 + hi) ^ swz) << 4);
    const int q4 = (lane >> 2) & 3, gb = (lane >> 4) & 1, p4 = lane & 3;
    int vaddr[2];
#pragma unroll
    for (int d = 0; d < 2; ++d) vaddr[d] = (4 * hi + q4) * 128 + ((d ^ (q4 >> 1)) << 6) + 32 * gb + 8 * p4;
    __syncthreads();
    asm volatile("s_waitcnt vmcnt(0)" ::: "memory");
#pragma unroll
    for (int i = 0; i < 6; ++i) if (i < NT) DIL_ISSUE(i, i);
    for (int t = 0; t < NT; ++t) {
        { const int rem = NT - 1 - t;
          if (rem >= 5) asm volatile("s_waitcnt vmcnt(10)" ::: "memory"); else if (rem == 4) asm volatile("s_waitcnt vmcnt(8)" ::: "memory");
          else if (rem == 3) asm volatile("s_waitcnt vmcnt(6)" ::: "memory"); else if (rem == 2) asm volatile("s_waitcnt vmcnt(4)" ::: "memory");
          else if (rem == 1) asm volatile("s_waitcnt vmcnt(2)" ::: "memory"); else asm volatile("s_waitcnt vmcnt(0)" ::: "memory"); }
        __builtin_amdgcn_s_barrier(); asm volatile("" ::: "memory");
        if (t + 6 < NT) DIL_ISSUE(t + 6, (t + 6) & 7);
        const int k0 = kstart + t * 64;
        {
            const LAS unsigned char* B = lds + (t & 7) * 16384;
            f32x16 p0, p1;
#pragma unroll
            for (int d0 = 0; d0 < 4; ++d0) {
                const bf16x8 ka = *(const LAS bf16x8*)(B + kaddr[d0]);
                const bf16x8 kb = *(const LAS bf16x8*)(B + 4096 + kaddr[d0]);
                if (d0 == 0) { p0 = MFMA32(ka, qf[d0], am); p1 = MFMA32(kb, qf[d0], am); }
                else { p0 = MFMA32(ka, qf[d0], p0); p1 = MFMA32(kb, qf[d0], p1); }
            }
            const bool interior = (k0 + 63 - blk <= 64 * DIL) && (blk + 255 - k0 <= 64 * DIL);
            if (!interior) {
                const int dd = k0 + 4 * hi - tq;
#pragma unroll
                for (int r = 0; r < 16; ++r) {
                    const int d0_ = dd + (r & 3) + 8 * (r >> 2), d1_ = d0_ + 32;
                    const bool v0 = (d0_ <= 64 * DIL) && (d0_ >= -64 * DIL);
                    const bool v1 = (d1_ <= 64 * DIL) && (d1_ >= -64 * DIL);
                    p0[r] = v0 ? p0[r] : -INFINITY; p1[r] = v1 ? p1[r] : -INFINITY;
                }
            }
            const bool resc = softmax_tile<8>(p0, p1, m_run, l_run, wsf, r32, hi);
            const bf16x8 pa0 = pack8(p0, 0), pa1 = pack8(p0, 8), pa2 = pack8(p1, 0), pa3 = pack8(p1, 8);
            if (resc) {
#pragma unroll
                for (int r = 0; r < 16; ++r) { const float f = wsf[crow(r, hi)]; o[0][r] *= f; o[1][r] *= f; }
            }
#pragma unroll
            for (int d = 0; d < 2; ++d) {
                const LAS unsigned char* vb = B + 8192 + vaddr[d];
                s16x4 lo, h4; bf16x8 vf;
                lo = vtr(vb + 0 * 2048); h4 = vtr(vb + 0 * 2048 + 1024); vf = (bf16x8){lo[0], lo[1], lo[2], lo[3], h4[0], h4[1], h4[2], h4[3]}; o[d] = MFMA32(pa0, vf, o[d]);
                lo = vtr(vb + 1 * 2048); h4 = vtr(vb + 1 * 2048 + 1024); vf = (bf16x8){lo[0], lo[1], lo[2], lo[3], h4[0], h4[1], h4[2], h4[3]}; o[d] = MFMA32(pa1, vf, o[d]);
                lo = vtr(vb + 2 * 2048); h4 = vtr(vb + 2 * 2048 + 1024); vf = (bf16x8){lo[0], lo[1], lo[2], lo[3], h4[0], h4[1], h4[2], h4[3]}; o[d] = MFMA32(pa2, vf, o[d]);
                lo = vtr(vb + 3 * 2048); h4 = vtr(vb + 3 * 2048 + 1024); vf = (bf16x8){lo[0], lo[1], lo[2], lo[3], h4[0], h4[1], h4[2], h4[3]}; o[d] = MFMA32(pa3, vf, o[d]);
            }
        }
    }
#undef DIL_ISSUE
}
__device__ __forceinline__ void dil_group4(size_t rowbase, int hg, int qb, const bf16_t* Z, LAS unsigned char* lds, float& m_run, float& l_run, f32x16 (&o)[2],
                                           int lane, int r32, int hi, int w, LAS float* wsf) {
    const int head = 4 + hg;
    const int blk = qb * 256, tq = blk + 16 * (r32 >> 1) + 2 * w + (r32 & 1);
    bf16x8 qf[4];
    { const bf16_t* qp = Z + (rowbase + tq) * ZP + ZC_QD + head * 64 + hi * 8;
#pragma unroll
      for (int d0 = 0; d0 < 4; ++d0) qf[d0] = *(const bf16x8*)(qp + d0 * 16); }
    f32x16 am;
#pragma unroll
    for (int r = 0; r < 16; ++r) am[r] = (((r ^ r32) & 1) == 0) ? 0.f : -INFINITY;
    int kstart = blk - 256; if (kstart < 0) kstart = 0;
    int kend = blk + 512; if (kend > SEQ) kend = SEQ;
    const int NST = (kend - kstart) >> 7;
    const int X = w & 1;
    const int kkl = 8 * w + (lane >> 3);
    const int tokoff = 4 * (kkl >> 1) + (kkl & 1);
    const bf16_t* kbase = Z + (rowbase + kstart + tokoff) * ZP + ZC_KD + head * 64 + (((lane & 7) ^ ((kkl >> 1) & 7)) << 3);
    const bf16_t* vbase = Z + (rowbase + kstart + tokoff) * ZP + ZC_VD + head * 64 + (((lane & 7) ^ (((kkl >> 1) & 1) << 2)) << 3);
    const unsigned wl = (unsigned)w * 1024u;
#define D4_ISSUE(st, slot) do { const size_t _o = (size_t)(st) * 128 * ZP; LAS unsigned char* _b = lds + (slot) * 32768; \
        GLDS16A(kbase + _o, _b + wl); GLDS16A(vbase + _o, _b + 8192 + wl); \
        GLDS16A(kbase + _o + (size_t)2 * ZP, _b + 16384 + wl); GLDS16A(vbase + _o + (size_t)2 * ZP, _b + 16384 + 8192 + wl); } while (0)
    const int swz = (r32 >> 1) & 7;
    int kaddr[4];
#pragma unroll
    for (int d0 = 0; d0 < 4; ++d0) kaddr[d0] = r32 * 128 + (((2 * d0 + hi) ^ swz) << 4);
    const int q4 = (lane >> 2) & 3, gb = (lane >> 4) & 1, p4 = lane & 3;
    int vaddr[2];
#pragma unroll
    for (int d = 0; d < 2; ++d) vaddr[d] = (4 * hi + q4) * 128 + ((d ^ (q4 >> 1)) << 6) + 32 * gb + 8 * p4;
    __syncthreads();
    asm volatile("s_waitcnt vmcnt(0)" ::: "memory");
#pragma unroll
    for (int i = 0; i < 3; ++i) if (i < NST) D4_ISSUE(i, i);
    for (int st = 0; st < NST; ++st) {
        { const int rem = NST - 1 - st;
          if (rem >= 2) asm volatile("s_waitcnt vmcnt(8)" ::: "memory"); else if (rem == 1) asm volatile("s_waitcnt vmcnt(4)" ::: "memory"); else asm volatile("s_waitcnt vmcnt(0)" ::: "memory"); }
        __builtin_amdgcn_s_barrier(); asm volatile("" ::: "memory");
        if (st + 3 < NST) D4_ISSUE(st + 3, (st + 3) & 3);
        const LAS unsigned char* B = lds + (st & 3) * 32768 + X * 16384;
        const int dT = kstart + st * 128 - blk;
        f32x16 p0, p1;
#pragma unroll
        for (int d0 = 0; d0 < 4; ++d0) {
            const bf16x8 ka = *(const LAS bf16x8*)(B + kaddr[d0]);
            const bf16x8 kb = *(const LAS bf16x8*)(B + 4096 + kaddr[d0]);
            if (d0 == 0) { p0 = MFMA32(ka, qf[d0], am); p1 = MFMA32(kb, qf[d0], am); }
            else { p0 = MFMA32(ka, qf[d0], p0); p1 = MFMA32(kb, qf[d0], p1); }
        }
        if (dT < -2 || dT > 132) {
            const int dd = dT - 16 * (r32 >> 1) + 2 * X - 2 * w;
#pragma unroll
            for (int r = 0; r < 16; ++r) { const int kk = (r & 3) + 8 * (r >> 2) + 4 * hi; const int d0_ = dd + 4 * (kk >> 1), d1_ = d0_ + 64;
                p0[r] = (d0_ <= 256 && d0_ >= -256) ? p0[r] : -INFINITY; p1[r] = (d1_ <= 256 && d1_ >= -256) ? p1[r] : -INFINITY; }
        }
        const bool resc = softmax_tile<8>(p0, p1, m_run, l_run, wsf, r32, hi);
        const bf16x8 pa0 = pack8(p0, 0), pa1 = pack8(p0, 8), pa2 = pack8(p1, 0), pa3 = pack8(p1, 8);
        if (resc) {
#pragma unroll
            for (int r = 0; r < 16; ++r) { const float f = wsf[crow(r, hi)]; o[0][r] *= f; o[1][r] *= f; }
        }
#pragma unroll
        for (int d = 0; d < 2; ++d) {
            const LAS unsigned char* vb = B + 8192 + vaddr[d];
            s16x4 lo, h4; bf16x8 vf;
            lo = vtr(vb + 0 * 2048); h4 = vtr(vb + 0 * 2048 + 1024); vf = (bf16x8){lo[0], lo[1], lo[2], lo[3], h4[0], h4[1], h4[2], h4[3]}; o[d] = MFMA32(pa0, vf, o[d]);
            lo = vtr(vb + 1 * 2048); h4 = vtr(vb + 1 * 2048 + 1024); vf = (bf16x8){lo[0], lo[1], lo[2], lo[3], h4[0], h4[1], h4[2], h4[3]}; o[d] = MFMA32(pa1, vf, o[d]);
            lo = vtr(vb + 2 * 2048); h4 = vtr(vb + 2 * 2048 + 1024); vf = (bf16x8){lo[0], lo[1], lo[2], lo[3], h4[0], h4[1], h4[2], h4[3]}; o[d] = MFMA32(pa2, vf, o[d]);
            lo = vtr(vb + 3 * 2048); h4 = vtr(vb + 3 * 2048 + 1024); vf = (bf16x8){lo[0], lo[1], lo[2], lo[3], h4[0], h4[1], h4[2], h4[3]}; o[d] = MFMA32(pa3, vf, o[d]);
        }
    }
#undef D4_ISSUE
}
__device__ __forceinline__ void dil_group16(size_t rowbase, int hg, int qb, const bf16_t* Z, LAS unsigned char* lds, float& m_run, float& l_run, f32x16 (&o)[2],
                                            int lane, int r32, int hi, int w, LAS float* wsf) {
    const int head = 8 + hg;
    const int blk = qb * 256, tq = blk + 16 * (r32 >> 1) + 2 * w + (r32 & 1);
    bf16x8 qf[4];
    { const bf16_t* qp = Z + (rowbase + tq) * ZP + ZC_QD + head * 64 + hi * 8;
#pragma unroll
      for (int d0 = 0; d0 < 4; ++d0) qf[d0] = *(const bf16x8*)(qp + d0 * 16); }
    f32x16 am;
#pragma unroll
    for (int r = 0; r < 16; ++r) am[r] = (((r ^ r32) & 1) == 0) ? 0.f : -INFINITY;
    int kstart = blk - 1024; if (kstart < 0) kstart = 0;
    int kend = blk + 256 + 1024; if (kend > SEQ) kend = SEQ;
    const int NST = (kend - kstart) >> 8;
    const int i4 = lane >> 4;
    const int rowoff = 16 * i4 + 2 * w + ((lane >> 3) & 1);
    const int kch = (lane & 7) ^ i4;
    const bf16_t* kbase = Z + (rowbase + kstart + rowoff) * ZP + ZC_KD + head * 64;
    const bf16_t* vbase = Z + (rowbase + kstart + rowoff) * ZP + ZC_VD + head * 64 + (((lane & 7) ^ ((i4 & 1) << 2)) << 3);
    LAS unsigned char* reg = lds + w * 16384;
#define D16_ISSUE(st, buf) do { const size_t _o = (size_t)(st) * 256 * ZP; LAS unsigned char* _b = reg + (buf) * 8192; \
        _Pragma("unroll") for (int j = 0; j < 4; ++j) { GLDS16A(kbase + _o + (size_t)j * 64 * ZP + (((j & 1) ? (kch ^ 4) : kch) << 3), _b + j * 1024); \
                                                        GLDS16A(vbase + _o + (size_t)j * 64 * ZP, _b + 4096 + j * 1024); } } while (0)
    const int swz = (r32 >> 1) & 7;
    int kaddr[4];
#pragma unroll
    for (int d0 = 0; d0 < 4; ++d0) kaddr[d0] = r32 * 128 + (((2 * d0 + hi) ^ swz) << 4);
    const int q4 = (lane >> 2) & 3, gb = (lane >> 4) & 1, p4 = lane & 3;
    int vaddr[2];
#pragma unroll
    for (int d = 0; d < 2; ++d) vaddr[d] = (4 * hi + q4) * 128 + ((d ^ (q4 >> 1)) << 6) + 32 * gb + 8 * p4;
    __syncthreads();
    asm volatile("s_waitcnt vmcnt(0)" ::: "memory");
    D16_ISSUE(0, 0);
    for (int st = 0; st < NST; ++st) {
        if (st + 1 < NST) { D16_ISSUE(st + 1, (st + 1) & 1); asm volatile("s_waitcnt vmcnt(8)" ::: "memory"); }
        else asm volatile("s_waitcnt vmcnt(0)" ::: "memory");
        const LAS unsigned char* B = reg + (st & 1) * 8192;
        const int dT = kstart + st * 256 - blk;
        f32x16 p0;
#pragma unroll
        for (int d0 = 0; d0 < 4; ++d0) { const bf16x8 ka = *(const LAS bf16x8*)(B + kaddr[d0]);
            if (d0 == 0) p0 = MFMA32(ka, qf[d0], am); else p0 = MFMA32(ka, qf[d0], p0); }
        if (dT < -768 || dT > 768) {
#pragma unroll
            for (int r = 0; r < 16; ++r) { const int kk = (r & 3) + 8 * (r >> 2) + 4 * hi; const int d = dT + 16 * ((kk >> 1) - (r32 >> 1));
                p0[r] = (d <= 1024 && d >= -1024) ? p0[r] : -INFINITY; }
        }
        float rm = max3f(p0[0], p0[1], p0[2]);
#pragma unroll
        for (int r = 3; r < 15; r += 2) rm = max3f(rm, p0[r], p0[r + 1]);
        rm = halfmax(max2f(rm, p0[15]));
        const bool resc = __any(rm > m_run + 8.f);
        if (resc) { const float mn = max2f(m_run, rm); const float f = fast_exp2(m_run - mn); m_run = mn; l_run *= f; if (hi == 0) wsf[r32] = f; }
        const float mm = m_run; float sm = 0.f;
#pragma unroll
        for (int r = 0; r < 16; ++r) { p0[r] = fast_exp2(p0[r] - mm); sm += p0[r]; }
        l_run += sm;
        const bf16x8 pa0 = pack8(p0, 0), pa1 = pack8(p0, 8);
        if (resc) {
#pragma unroll
            for (int r = 0; r < 16; ++r) { const float f = wsf[crow(r, hi)]; o[0][r] *= f; o[1][r] *= f; }
        }
#pragma unroll
        for (int d = 0; d < 2; ++d) {
            const LAS unsigned char* vb = B + 4096 + vaddr[d];
            s16x4 lo, h4; bf16x8 vf;
            lo = vtr(vb); h4 = vtr(vb + 1024); vf = (bf16x8){lo[0], lo[1], lo[2], lo[3], h4[0], h4[1], h4[2], h4[3]}; o[d] = MFMA32(pa0, vf, o[d]);
            lo = vtr(vb + 2048); h4 = vtr(vb + 2048 + 1024); vf = (bf16x8){lo[0], lo[1], lo[2], lo[3], h4[0], h4[1], h4[2], h4[3]}; o[d] = MFMA32(pa1, vf, o[d]);
        }
    }
#undef D16_ISSUE
}
__device__ __forceinline__ void dil_unit(int b, int hg, int qb, bf16_t* Z, LAS unsigned char* lds) {
    const int tid = threadIdx.x, lane = tid & 63, r32 = lane & 31, hi = lane >> 5;
    const int w = __builtin_amdgcn_readfirstlane(tid >> 6);
    const size_t rowbase = (size_t)b * SEQ;
    LAS float* wsf = (LAS float*)(lds + 131072) + w * 64;
    float m_run = -1e30f, l_run = 0.f;
    f32x16 o[2];
#pragma unroll
    for (int d = 0; d < 2; ++d)
#pragma unroll
        for (int r = 0; r < 16; ++r) o[d][r] = 0.f;
    dil_group<1>(0, rowbase, hg, qb, Z, lds, m_run, l_run, o, lane, r32, hi, w, wsf);
    dil_group4(rowbase, hg, qb, Z, lds, m_run, l_run, o, lane, r32, hi, w, wsf);
    dil_group16(rowbase, hg, qb, Z, lds, m_run, l_run, o, lane, r32, hi, w, wsf);
    const float lt = halfsum(l_run);
    if (hi == 0) wsf[r32] = fast_rcp(lt);
    bf16_t* op = Z + (rowbase + qb * 256 + 2 * w) * ZP + ZC_QD + hg * 64 + r32;
#pragma unroll
    for (int r = 0; r < 16; ++r) { const int q = crow(r, hi); const float il = wsf[q]; const int trow = 16 * (q >> 1) + (q & 1);
#pragma unroll
        for (int d = 0; d < 2; ++d) { const unsigned pk = cvtpk(o[d][r] * il, 0.f); op[(size_t)trow * ZP + d * 32] = (bf16_t)(pk & 0xffffu); } }
    __syncthreads();
}

__device__ __forceinline__ void ld_f32_row(const float* row, int lane, f32x4 (&v)[4]) {
    const f32x4* p = (const f32x4*)row + lane;
#pragma unroll
    for (int j = 0; j < 4; ++j) v[j] = p[64 * j];
}
__device__ __forceinline__ void ld_bf16_row(const bf16_t* row, int lane, f32x4 (&v)[4]) {
    const u32x2* p = (const u32x2*)row + lane;
#pragma unroll
    for (int j = 0; j < 4; ++j) { const u32x2 w = p[64 * j]; v[j] = (f32x4){bflo(w.x), bfhi(w.x), bflo(w.y), bfhi(w.y)}; }
}
__device__ __forceinline__ void st_f32_row(float* row, int lane, const f32x4 (&v)[4]) {
    f32x4* p = (f32x4*)row + lane;
#pragma unroll
    for (int j = 0; j < 4; ++j) p[64 * j] = v[j];
}
__device__ __forceinline__ void st_bf16_row(bf16_t* row, int lane, const f32x4 (&v)[4]) {
    u32x2* p = (u32x2*)row + lane;
#pragma unroll
    for (int j = 0; j < 4; ++j) { u32x2 w; w.x = cvtpk(v[j][0], v[j][1]); w.y = cvtpk(v[j][2], v[j][3]); p[64 * j] = w; }
}
__device__ __forceinline__ float row_rstd(const f32x4 (&v)[4]) {
    float s = 0.f;
#pragma unroll
    for (int j = 0; j < 4; ++j) s += (v[j][0] * v[j][0] + v[j][1] * v[j][1]) + (v[j][2] * v[j][2] + v[j][3] * v[j][3]);
    return 1.0f / sqrtf(wave_sum(s) * (1.f / DM) + EPS);
}
__device__ __forceinline__ void add_normed(f32x4 (&acc)[4], const f32x4 (&y)[4], const float* g, int lane, float scale) {
    const float r = row_rstd(y) * scale; f32x4 gv[4]; ld_f32_row(g, lane, gv);
#pragma unroll
    for (int j = 0; j < 4; ++j) acc[j] = acc[j] + y[j] * r * gv[j];
}
__device__ __forceinline__ void norm_to_bf16(const f32x4 (&x)[4], const float* g, int lane, bf16_t* orow) {
    const float r = row_rstd(x); f32x4 gv[4]; ld_f32_row(g, lane, gv); f32x4 t[4];
#pragma unroll
    for (int j = 0; j < 4; ++j) t[j] = x[j] * r * gv[j];
    st_bf16_row(orow, lane, t);
}

__device__ __forceinline__ int gu_map(int n0) { return n0 < DFF ? (((n0 >> 7) << 8) + (n0 & 127)) : ((((n0 - DFF) >> 7) << 8) + 128 + ((n0 - DFF) & 127)); }
template <bool GU>
__device__ __forceinline__ void transpose_item(const float* W, int K, int N, bf16_t* WT, LAS float* scr, int item, int lane) {
    const int nblk = N / 32, kb = item / nblk, nb = item % nblk, k0 = 64 * kb, n0 = 32 * nb;
    const int r0 = GU ? gu_map(n0) : n0;
#pragma unroll 8
    for (int i = 0; i < 32; ++i) { const int kk = 2 * i + (lane >> 5); scr[kk * 33 + (lane & 31)] = W[(size_t)(k0 + kk) * N + n0 + (lane & 31)]; }
    asm volatile("s_waitcnt lgkmcnt(0)" ::: "memory");
    const int c = lane & 7;
#pragma unroll
    for (int j = 0; j < 4; ++j) { const int n = (lane >> 3) + 8 * j; const LAS float* s = scr + (8 * c) * 33 + n;
        u32x4 o; o.x = cvtpk(s[0 * 33], s[1 * 33]); o.y = cvtpk(s[2 * 33], s[3 * 33]); o.z = cvtpk(s[4 * 33], s[5 * 33]); o.w = cvtpk(s[6 * 33], s[7 * 33]);
        *(u32x4*)(WT + (size_t)(r0 + n) * K + k0 + 8 * c) = o; }
    asm volatile("s_waitcnt lgkmcnt(0)" ::: "memory");
}
__device__ __forceinline__ void sincos_d(double a, float& c, float& s) {
    const double TWO_PI = 6.283185307179586476925, INV_2PI = 0.15915494309189533577;
    const double k = __builtin_rint(a * INV_2PI); const double r = a - k * TWO_PI, r2 = r * r;
    double sp = -1.0 / 121645100408832000.0;
    sp = sp * r2 + 1.0 / 355687428096000.0; sp = sp * r2 - 1.0 / 1307674368000.0; sp = sp * r2 + 1.0 / 6227020800.0; sp = sp * r2 - 1.0 / 39916800.0;
    sp = sp * r2 + 1.0 / 362880.0; sp = sp * r2 - 1.0 / 5040.0; sp = sp * r2 + 1.0 / 120.0; sp = sp * r2 - 1.0 / 6.0; sp = sp * r2 + 1.0;
    double cp = 1.0 / 2432902008176640000.0;
    cp = cp * r2 - 1.0 / 6402373705728000.0; cp = cp * r2 + 1.0 / 20922789888000.0; cp = cp * r2 - 1.0 / 87178291200.0; cp = cp * r2 + 1.0 / 479001600.0;
    cp = cp * r2 - 1.0 / 3628800.0; cp = cp * r2 + 1.0 / 40320.0; cp = cp * r2 - 1.0 / 720.0; cp = cp * r2 + 1.0 / 24.0; cp = cp * r2 - 0.5; cp = cp * r2 + 1.0;
    s = (float)(sp * r); c = (float)cp;
}

constexpr int N_PHASES = 12;

__device__ __forceinline__ bool ph_in(int k) {
    kargs_t p = (kargs_t)__builtin_amdgcn_kernarg_segment_ptr(); asm volatile("" : "+s"(p)); return p->ph_lo <= k && k < p->ph_hi;
}
__device__ __forceinline__ void grid_bar(unsigned* bar, unsigned G) {
    asm volatile("s_waitcnt vmcnt(0)" ::: "memory");
    __syncthreads();
    if (threadIdx.x == 0) {
        __builtin_amdgcn_fence(__ATOMIC_RELEASE, "agent");
        const unsigned gen = __hip_atomic_load(bar + 64, __ATOMIC_RELAXED, __HIP_MEMORY_SCOPE_AGENT);
        const unsigned old = __hip_atomic_fetch_add(bar, 1u, __ATOMIC_RELAXED, __HIP_MEMORY_SCOPE_AGENT);
        if (old == G - 1u) {
            __hip_atomic_store(bar, 0u, __ATOMIC_RELAXED, __HIP_MEMORY_SCOPE_AGENT);
            __hip_atomic_fetch_add(bar + 64, 1u, __ATOMIC_RELEASE, __HIP_MEMORY_SCOPE_AGENT);
        } else {
            unsigned spins = 0;
            while (__hip_atomic_load(bar + 64, __ATOMIC_RELAXED, __HIP_MEMORY_SCOPE_AGENT) == gen) { __builtin_amdgcn_s_sleep(2); if (++spins > (1u << 26)) break; }
        }
        __builtin_amdgcn_fence(__ATOMIC_ACQUIRE, "agent");
        asm volatile("s_waitcnt vmcnt(0)" ::: "memory");
    }
    __syncthreads();
}
__global__ void __launch_bounds__(NTHREADS) fwd_megakernel(Args a) {
    extern __shared__ __attribute__((aligned(16))) unsigned char lds_raw[];
    LAS unsigned char* lds = (LAS unsigned char*)lds_raw;
    cg::grid_group grid = cg::this_grid();
#define PHASE_PTRS() int tid = threadIdx.x; asm volatile("" : "+v"(tid)); const int lane = tid & 63, wave = __builtin_amdgcn_readfirstlane(tid >> 6); \
    int bx = blockIdx.x; asm volatile("" : "+s"(bx)); const int G = gridDim.x; \
    const int vcu = (G % 8 == 0) ? (bx % 8) * (G / 8) + bx / 8 : bx; const int gw = vcu * 8 + wave, NGW = G * 8; (void)lane; (void)gw; (void)NGW; (void)vcu; \
    kargs_t ka = (kargs_t)__builtin_amdgcn_kernarg_segment_ptr(); asm volatile("" : "+s"(ka)); \
    unsigned char* ws = ka->ws; float* out = ka->out; const float* x = ka->in[IN_X]; (void)x; (void)out; \
    bf16_t* XN = (bf16_t*)(ws + WS_XN); bf16_t* Y1 = (bf16_t*)(ws + WS_Y1); bf16_t* Zb = (bf16_t*)(ws + WS_Z); bf16_t* Gb = (bf16_t*)out; \
    (void)XN; (void)Y1; (void)Zb; (void)Gb
#ifndef PHASE_MASK
#define PHASE_MASK 0xFFF
#endif
#define IN(k) (((PHASE_MASK >> (k)) & 1) && ph_in(k))
#define SEAM(k) do { if (IN(k) && IN((k) + 1)) { if ((k) == 0) grid.sync(); else grid_bar((unsigned*)a.ws, gridDim.x); } } while (0)

    if (IN(0)) {
        PHASE_PTRS();
        bf16_t* Win_t = (bf16_t*)(ws + WS_WIN); bf16_t* Wpa_t = (bf16_t*)(ws + WS_WPA); bf16_t* Wpb_t = (bf16_t*)(ws + WS_WPB); bf16_t* Wout_t = (bf16_t*)(ws + WS_WOUT);
        bf16_t* Wgu2_t = (bf16_t*)(ws + WS_WGU2); bf16_t* Wd2_t = (bf16_t*)(ws + WS_WD2);
        bf16_t* Wgu1_t = (bf16_t*)((unsigned char*)out + OUT_WGU1); bf16_t* Wd1_t = (bf16_t*)((unsigned char*)out + OUT_WD1);
        float* rope = (float*)(ws + WS_ROPE);
        LAS float* scr = (LAS float*)(lds + wave * 16384);
        constexpr int I_IN = 16 * (NIN / 32), I_SQ = 16 * 32, I_PB = 4 * 32, I_GU = 16 * (NGU / 32), I_DN = (DFF / 64) * 32;
        constexpr int NITEMS = I_IN + 2 * I_SQ + I_PB + 2 * I_GU + 2 * I_DN;
        for (int it = gw; it < NITEMS; it += NGW) {
            int r = it;
            if (r < I_GU) { transpose_item<true>(ka->in[IN_WGU1], DM, NGU, Wgu1_t, scr, r, lane); continue; } r -= I_GU;
            if (r < I_DN) { transpose_item<false>(ka->in[IN_WD1], DFF, DM, Wd1_t, scr, r, lane); continue; } r -= I_DN;
            if (r < I_IN) { transpose_item<false>(ka->in[IN_WIN], DM, NIN, Win_t, scr, r, lane); continue; } r -= I_IN;
            if (r < I_SQ) { transpose_item<false>(ka->in[IN_WPA], DM, DM, Wpa_t, scr, r, lane); continue; } r -= I_SQ;
            if (r < I_PB) { transpose_item<false>(ka->in[IN_WPB], 256, DM, Wpb_t, scr, r, lane); continue; } r -= I_PB;
            if (r < I_SQ) { transpose_item<false>(ka->in[IN_WOUT], DM, DM, Wout_t, scr, r, lane); continue; } r -= I_SQ;
            if (r < I_GU) { transpose_item<true>(ka->in[IN_WGU2], DM, NGU, Wgu2_t, scr, r, lane); continue; } r -= I_GU;
            transpose_item<false>(ka->in[IN_WD2], DFF, DM, Wd2_t, scr, r, lane);
        }
        {
            const int* pos = (const int*)ka->in[IN_POS];
            const float invf[8] = {1.0f, 0.1939227432012558f, 0.03760603070259094f, 0.007292664609849453f, 0.0014142135623842478f, 0.00027424818836152554f, 5.3182957344688475e-05f, 1.0313385246263351e-05f};
            for (int i = bx * NTHREADS + tid; i < MROWS * 8; i += G * NTHREADS) {
                const int row = i >> 3, f = i & 7;
                float fv = invf[0];
#pragma unroll
                for (int q = 1; q < 8; ++q) fv = (f == q) ? invf[q] : fv;
                const float ang = (float)pos[row] * fv; float c, s; sincos_d((double)ang, c, s);
                rope[(size_t)row * 16 + f] = c; rope[(size_t)row * 16 + 8 + f] = s;
            }
        }
        for (int m = gw; m < MROWS; m += NGW) { f32x4 v[4]; ld_f32_row(x + (size_t)m * DM, lane, v); norm_to_bf16(v, ka->in[IN_GPRE1], lane, XN + (size_t)m * DM); }
        if (bx == 0 && tid == 0) { __hip_atomic_store((unsigned*)ws, 0u, __ATOMIC_RELAXED, __HIP_MEMORY_SCOPE_AGENT); __hip_atomic_store((unsigned*)ws + 64, 0u, __ATOMIC_RELAXED, __HIP_MEMORY_SCOPE_AGENT); }
        __syncthreads();
    }
    SEAM(0);
    if (IN(1)) {
        PHASE_PTRS(); bf16_t* Hb = Zb; bf16_t* Wgu1_t = (bf16_t*)((unsigned char*)out + OUT_WGU1);
        pg8::Gemm g{XN, Wgu1_t, MROWS, NGU, DM, DM}; pg8::StaticOrder S; S.init(MROWS, NGU, G, bx);
        pg8::EpiT<pg8::EPI_SWIGLU> E{Hb, DFF, nullptr, nullptr};
        pg8::gemm_phase<pg8::EpiT<pg8::EPI_SWIGLU>, true>(lds, g, S, E);
    }
    SEAM(1);
    if (IN(2)) {
        PHASE_PTRS(); bf16_t* Hb = Zb; bf16_t* Wd1_t = (bf16_t*)((unsigned char*)out + OUT_WD1);
        pg8::Gemm g{Hb, Wd1_t, MROWS, DM, DFF, DFF}; pg8::StaticOrder S; S.init(MROWS, DM, G, bx);
        pg8::EpiT<pg8::EPI_PLAIN> E{Y1, DM, nullptr, nullptr};
        pg8::gemm_phase<pg8::EpiT<pg8::EPI_PLAIN>, true>(lds, g, S, E);
    }
    SEAM(2);
    if (IN(3)) {
        PHASE_PTRS();
        for (int m = gw; m < MROWS; m += NGW) {
            f32x4 xv[4], y[4]; ld_f32_row(x + (size_t)m * DM, lane, xv); ld_bf16_row(Y1 + (size_t)m * DM, lane, y);
            add_normed(xv, y, ka->in[IN_GPOST1], lane, 0.5f);
            norm_to_bf16(xv, ka->in[IN_GPREM], lane, XN + (size_t)m * DM);
        }
    }
    SEAM(3);
    if (IN(4)) {
        PHASE_PTRS(); bf16_t* Win_t = (bf16_t*)(ws + WS_WIN); float* rope = (float*)(ws + WS_ROPE);
        pg8::Gemm g{XN, Win_t, MROWS, NIN, DM, DM}; pg8::StaticOrder S; S.init(MROWS, NIN, G, bx);
        pg8::EpiT<pg8::EPI_WIN> E{Zb, ZP, Gb, rope};
        pg8::gemm_phase<pg8::EpiT<pg8::EPI_WIN>, true>(lds, g, S, E);
    }
    SEAM(4);
    if (IN(5)) {
        PHASE_PTRS();
        float lam;
        { const float d1 = wave_sum(ka->in[IN_LQ1][lane] * ka->in[IN_LK1][lane]), d2 = wave_sum(ka->in[IN_LQ2][lane] * ka->in[IN_LK2][lane]);
          lam = fast_exp2(d1 * LOG2E) - fast_exp2(d2 * LOG2E) + LAMBDA_INIT; }
#ifndef NO_DIL
        for (int u = vcu; u < BATCH * 4 * 32; u += G) { const int bh = u >> 5, qb = u & 31; dil_unit(bh >> 2, bh & 3, qb, Zb, lds); }
#endif
        __syncthreads();
#ifndef NO_DIFF
        for (int u = vcu; u < BATCH * 8 * 32; u += G) { const int bh = u >> 5, qb = u & 31; diff_unit<8>(bh >> 3, bh & 7, qb, Zb, ka->in[IN_GSUB], lam, lds); }
#endif
        __syncthreads();
    }
    SEAM(5);
    if (IN(6)) {
        PHASE_PTRS(); bf16_t* MERGED = XN; bf16_t* Wpa_t = (bf16_t*)(ws + WS_WPA); bf16_t* Wpb_t = (bf16_t*)(ws + WS_WPB);
#ifndef NO_PB
        { int kpb = 256; asm volatile("" : "+s"(kpb));
          pg8::Gemm g{Zb + ZC_QD, Wpb_t, MROWS, DM, kpb, ZP}; pg8::StaticOrder S; S.init(MROWS, DM, G, bx);
          pg8::EpiT<pg8::EPI_PROJB> E{MERGED, DM, Gb, nullptr};
          pg8::gemm_phase<pg8::EpiT<pg8::EPI_PROJB>, true>(lds, g, S, E); }
#endif
#ifndef NO_PA
        { pg8::Gemm g{Zb, Wpa_t, MROWS, DM, DM, ZP}; pg8::StaticOrder S; S.init(MROWS, DM, G, bx);
          pg8::EpiT<pg8::EPI_PROJA> E{MERGED, DM, Gb, nullptr};
          pg8::gemm_phase<pg8::EpiT<pg8::EPI_PROJA>, true>(lds, g, S, E); }
#endif
    }
    SEAM(6);
    if (IN(7)) {
        PHASE_PTRS(); bf16_t* MERGED = XN; bf16_t* Y2 = Zb; bf16_t* Wout_t = (bf16_t*)(ws + WS_WOUT);
        pg8::Gemm g{MERGED, Wout_t, MROWS, DM, DM, DM}; pg8::StaticOrder S; S.init(MROWS, DM, G, bx);
        pg8::EpiT<pg8::EPI_PLAIN> E{Y2, DM, nullptr, nullptr};
        pg8::gemm_phase<pg8::EpiT<pg8::EPI_PLAIN>, true>(lds, g, S, E);
    }
    SEAM(7);
    if (IN(8)) {
        PHASE_PTRS(); bf16_t* Y2 = Zb;
        for (int m = gw; m < MROWS; m += NGW) {
            f32x4 xv[4], y[4]; ld_f32_row(x + (size_t)m * DM, lane, xv); ld_bf16_row(Y1 + (size_t)m * DM, lane, y);
            add_normed(xv, y, ka->in[IN_GPOST1], lane, 0.5f);
            ld_bf16_row(Y2 + (size_t)m * DM, lane, y);
            add_normed(xv, y, ka->in[IN_GPOSTM], lane, 1.0f);
            st_f32_row(out + (size_t)m * DM, lane, xv);
            norm_to_bf16(xv, ka->in[IN_GPRE2], lane, XN + (size_t)m * DM);
        }
    }
    SEAM(8);
    if (IN(9)) {
        PHASE_PTRS(); bf16_t* Hb = Zb; bf16_t* Wgu2_t = (bf16_t*)(ws + WS_WGU2);
        pg8::Gemm g{XN, Wgu2_t, MROWS, NGU, DM, DM}; pg8::StaticOrder S; S.init(MROWS, NGU, G, bx);
        pg8::EpiT<pg8::EPI_SWIGLU> E{Hb, DFF, nullptr, nullptr};
        pg8::gemm_phase<pg8::EpiT<pg8::EPI_SWIGLU>, true>(lds, g, S, E);
    }
    SEAM(9);
    if (IN(10)) {
        PHASE_PTRS(); bf16_t* Hb = Zb; bf16_t* Y3 = Y1; bf16_t* Wd2_t = (bf16_t*)(ws + WS_WD2);
        pg8::Gemm g{Hb, Wd2_t, MROWS, DM, DFF, DFF}; pg8::StaticOrder S; S.init(MROWS, DM, G, bx);
        pg8::EpiT<pg8::EPI_PLAIN> E{Y3, DM, nullptr, nullptr};
        pg8::gemm_phase<pg8::EpiT<pg8::EPI_PLAIN>, true>(lds, g, S, E);
    }
    SEAM(10);
    if (IN(11)) {
        PHASE_PTRS(); bf16_t* Y3 = Y1;
        for (int m = gw; m < MROWS; m += NGW) {
            f32x4 xv[4], y[4]; ld_f32_row(out + (size_t)m * DM, lane, xv); ld_bf16_row(Y3 + (size_t)m * DM, lane, y);
            add_normed(xv, y, ka->in[IN_GPOST2], lane, 0.5f);
            st_f32_row(out + (size_t)m * DM, lane, xv);
        }
    }
#undef IN
#undef SEAM
}

extern "C" void kernel_launch(void* const* d_in, const int* in_sizes, int n_in, void* d_out, int out_size, void* d_ws, size_t ws_size, hipStream_t stream) {
    static int grid = 0;
    if (grid == 0) {
        if (n_in != 21 || out_size != MROWS * DM || ws_size < WS_END) { fprintf(stderr, "kernel_launch: unexpected shapes (n_in %d out %d ws %zu)\n", n_in, out_size, ws_size); grid = -1; return; }
        int dev = 0, cus = 0, per_cu = 0;
        (void)hipGetDevice(&dev); (void)hipDeviceGetAttribute(&cus, hipDeviceAttributeMultiprocessorCount, dev);
        if (hipFuncSetAttribute((const void*)fwd_megakernel, hipFuncAttributeMaxDynamicSharedMemorySize, LDS_BYTES) != hipSuccess) { fprintf(stderr, "kernel_launch: hipFuncSetAttribute failed\n"); grid = -1; return; }
        if (hipOccupancyMaxActiveBlocksPerMultiprocessor(&per_cu, (const void*)fwd_megakernel, NTHREADS, LDS_BYTES) != hipSuccess || per_cu < 1) { fprintf(stderr, "kernel_launch: occupancy query says %d\n", per_cu); per_cu = 1; (void)hipGetLastError(); }
        grid = cus * per_cu;
    }
    if (grid < 0) return;
    Args a{};
    for (int i = 0; i < 21; ++i) a.in[i] = (const float*)d_in[i];
    a.out = (float*)d_out; a.ws = (unsigned char*)d_ws;
#if MK_N_LAUNCHES == 1
    a.ph_lo = 0; a.ph_hi = N_PHASES;
    void* args[] = {&a};
    hipError_t e = hipLaunchCooperativeKernel((const void*)fwd_megakernel, dim3(grid), dim3(NTHREADS), args, LDS_BYTES, stream);
    if (e != hipSuccess) fprintf(stderr, "cooperative launch failed: %s (grid %d)\n", hipGetErrorString(e), grid);
#else
    for (int p = 0; p < N_PHASES; ++p) { a.ph_lo = p; a.ph_hi = p + 1; hipLaunchKernelGGL(fwd_megakernel, dim3(grid), dim3(NTHREADS), LDS_BYTES, stream, a); }
#endif
}
```
